# Optimizing an MI355X kernel written in HIP

```python
import math
import jax, jax.numpy as jnp
from jax import lax
import numpy as np

D_MODEL = 1024
BATCH = 8
SEQ = 4096
DEPTH = 2

HEAD_DIM = 64
N_HEAD_SLOTS = D_MODEL // HEAD_DIM
MIX_WIDTH = N_HEAD_SLOTS * HEAD_DIM
HEADS_PER_MIXER = N_HEAD_SLOTS // 2
KV_HEADS = 2
GROUP = HEADS_PER_MIXER // KV_HEADS
HQ = HEADS_PER_MIXER * HEAD_DIM
KVW = KV_HEADS * HEAD_DIM
Q_BLOCK = 128
NSA_CMP_LEN = 32
NSA_CMP_STRIDE = 16
NSA_SEL_LEN = 64
NSA_SEL_TOP = 8
NSA_WINDOW = 512
NSA_FORCE = 1e4
SWA_WINDOW = 128
MOBA_BLOCK = 256
MOBA_TOP = 3
MOBA_Q_CHUNK = 32
REL_BUCKETS = 32
REL_MAX_DIST = 128
D_FF = ((8 * D_MODEL // 3 + 255) // 256) * 256
RMS_EPS = 1e-6
NEG = -1e30
AB_WIDTH = HQ + 6 * KVW + 3 * HEADS_PER_MIXER + HQ + 2 * KVW
CD_WIDTH = HQ + 2 * KVW + 3 * HQ
N_EVEN = (DEPTH + 1) // 2
N_ODD = DEPTH // 2

kernel_name = "hybrid_nsa_swa_moba_stickbreak_block"


def rms_norm(x, w):
    xf = x.astype(jnp.float32)
    y = xf * lax.rsqrt(jnp.mean(xf * xf, axis=-1, keepdims=True) + RMS_EPS)
    return (y * w.astype(jnp.float32)).astype(x.dtype)


def rel_bucket(dist):
    n = jnp.maximum(dist, 0)
    max_exact = REL_BUCKETS // 2
    nf = jnp.maximum(n, 1).astype(jnp.float32)
    large = max_exact + (jnp.log(nf / max_exact) / math.log(REL_MAX_DIST / max_exact)
                         * (REL_BUCKETS - max_exact)).astype(jnp.int32)
    large = jnp.minimum(large, REL_BUCKETS - 1)
    return jnp.where(n < max_exact, n, large)


def masked_softmax(s, valid):
    s = jnp.where(valid, s.astype(jnp.float32), NEG)
    p = jax.nn.softmax(s, axis=-1)
    return jnp.where(valid, p, 0.0)


def nsa_attention(q, k_cmp, v_cmp, k_sel, v_sel, k_win, v_win, gates, cmp_wk, cmp_wv, cmp_pe, rel_tab):
    B, S, H, dh = q.shape
    G, R = KV_HEADS, GROUP
    dt = q.dtype
    scale = HEAD_DIM ** -0.5
    n_cmp = (S - NSA_CMP_LEN) // NSA_CMP_STRIDE + 1
    cmp_start = jnp.arange(n_cmp) * NSA_CMP_STRIDE
    gidx = cmp_start[:, None] + jnp.arange(NSA_CMP_LEN)[None, :]
    kc = jnp.einsum('bnlgd,lde->bnge', k_cmp[:, gidx] + cmp_pe[:, None, :], cmp_wk)
    vc = jnp.einsum('bnlgd,lde->bnge', v_cmp[:, gidx] + cmp_pe[:, None, :], cmp_wv)
    cmp_end = cmp_start + NSA_CMP_LEN - 1
    n_sel = S // NSA_SEL_LEN
    sel_start = jnp.arange(n_sel) * NSA_SEL_LEN
    overlap = jnp.maximum(jnp.minimum(cmp_end[:, None] + 1, sel_start[None, :] + NSA_SEL_LEN)
                          - jnp.maximum(cmp_start[:, None], sel_start[None, :]), 0)
    overlap_w = overlap.astype(jnp.float32) / NSA_CMP_LEN
    top = min(NSA_SEL_TOP, n_sel)
    ksb = k_sel.reshape(B, n_sel, NSA_SEL_LEN, G, dh).transpose(0, 3, 1, 2, 4)
    vsb = v_sel.reshape(B, n_sel, NSA_SEL_LEN, G, dh).transpose(0, 3, 1, 2, 4)
    kw = jnp.pad(k_win, ((0, 0), (NSA_WINDOW, 0), (0, 0), (0, 0)))
    vw = jnp.pad(v_win, ((0, 0), (NSA_WINDOW, 0), (0, 0), (0, 0)))
    bi = jnp.arange(B)[:, None, None, None]
    gi = jnp.arange(G)[None, :, None, None]
    sb = jnp.arange(n_sel)

    def block(n):
        t0 = n * Q_BLOCK
        tq = t0 + jnp.arange(Q_BLOCK)
        qb = lax.dynamic_slice_in_dim(q, t0, Q_BLOCK, axis=1).reshape(B, Q_BLOCK, G, R, dh)
        gb = lax.dynamic_slice_in_dim(gates, t0, Q_BLOCK, axis=1).reshape(B, Q_BLOCK, G, R, 1, 3)
        dist = tq[:, None] - cmp_end[None, :]
        s = jnp.einsum('bqgrd,bngd->bgrqn', qb, kc) * scale
        s = s + rel_tab[rel_bucket(dist)].transpose(2, 3, 0, 1)
        p_cmp = masked_softmax(s, dist >= 0)
        o_cmp = jnp.einsum('bgrqn,bngd->bqgrd', p_cmp.astype(dt), vc)
        imp = jnp.einsum('bgrqn,ns->bgqs', p_cmp, overlap_w)
        own = tq // NSA_SEL_LEN
        forced = (sb[None, :] == 0) | (sb[None, :] == own[:, None]) | (sb[None, :] == own[:, None] - 1)
        causal_blk = sb[None, :] <= own[:, None]
        imp = jnp.where(causal_blk, imp + jnp.where(forced, NSA_FORCE, 0.0), NEG)
        _, sel = lax.top_k(imp, top)
        ks = ksb[bi, gi, sel].reshape(B, G, Q_BLOCK, top * NSA_SEL_LEN, dh)
        vs = vsb[bi, gi, sel].reshape(B, G, Q_BLOCK, top * NSA_SEL_LEN, dh)
        pos = (sel[..., None] * NSA_SEL_LEN + jnp.arange(NSA_SEL_LEN)).reshape(B, G, Q_BLOCK, top * NSA_SEL_LEN)
        dist = tq[None, None, :, None] - pos
        s = jnp.einsum('bqgrd,bgqkd->bgrqk', qb, ks) * scale
        s = s + rel_tab[rel_bucket(dist), gi].transpose(0, 1, 4, 2, 3)
        p = masked_softmax(s, (dist >= 0)[:, :, None])
        o_sel = jnp.einsum('bgrqk,bgqkd->bqgrd', p.astype(dt), vs)
        kwb = lax.dynamic_slice_in_dim(kw, t0, NSA_WINDOW + Q_BLOCK, axis=1)
        vwb = lax.dynamic_slice_in_dim(vw, t0, NSA_WINDOW + Q_BLOCK, axis=1)
        kpos = t0 - NSA_WINDOW + jnp.arange(NSA_WINDOW + Q_BLOCK)
        dist = tq[:, None] - kpos[None, :]
        valid = (dist >= 0) & (dist < NSA_WINDOW) & (kpos[None, :] >= 0)
        s = jnp.einsum('bqgrd,bkgd->bgrqk', qb, kwb) * scale
        s = s + rel_tab[rel_bucket(dist)].transpose(2, 3, 0, 1)
        p = masked_softmax(s, valid)
        o_win = jnp.einsum('bgrqk,bkgd->bqgrd', p.astype(dt), vwb)
        o = jnp.stack([o_cmp, o_sel, o_win], axis=-1)
        return jnp.sum(o * gb, axis=-1).reshape(B, Q_BLOCK, H * dh)

    out = lax.map(block, jnp.arange(S // Q_BLOCK))
    return out.transpose(1, 0, 2, 3).reshape(B, S, H * dh)


def swa_sink_attention(q, k, v, sinks, rel_tab):
    B, S, H, dh = q.shape
    G, R = KV_HEADS, GROUP
    dt = q.dtype
    scale = HEAD_DIM ** -0.5
    kp = jnp.pad(k, ((0, 0), (SWA_WINDOW, 0), (0, 0), (0, 0)))
    vp = jnp.pad(v, ((0, 0), (SWA_WINDOW, 0), (0, 0), (0, 0)))
    sink = jnp.broadcast_to(sinks.astype(jnp.float32).reshape(G, R)[None, :, :, None, None],
                            (B, G, R, Q_BLOCK, 1))

    def block(n):
        t0 = n * Q_BLOCK
        tq = t0 + jnp.arange(Q_BLOCK)
        qb = lax.dynamic_slice_in_dim(q, t0, Q_BLOCK, axis=1).reshape(B, Q_BLOCK, G, R, dh)
        kb = lax.dynamic_slice_in_dim(kp, t0, SWA_WINDOW + Q_BLOCK, axis=1)
        vb = lax.dynamic_slice_in_dim(vp, t0, SWA_WINDOW + Q_BLOCK, axis=1)
        kpos = t0 - SWA_WINDOW + jnp.arange(SWA_WINDOW + Q_BLOCK)
        dist = tq[:, None] - kpos[None, :]
        valid = (dist >= 0) & (dist < SWA_WINDOW) & (kpos[None, :] >= 0)
        s = jnp.einsum('bqgrd,bkgd->bgrqk', qb, kb) * scale
        s = s + rel_tab[rel_bucket(dist)].transpose(2, 3, 0, 1)
        s = jnp.where(valid, s.astype(jnp.float32), NEG)
        p = jax.nn.softmax(jnp.concatenate([s, sink], axis=-1), axis=-1)[..., :-1]
        o = jnp.einsum('bgrqk,bkgd->bqgrd', p.astype(dt), vb)
        return o.reshape(B, Q_BLOCK, H * dh)

    out = lax.map(block, jnp.arange(S // Q_BLOCK))
    return out.transpose(1, 0, 2, 3).reshape(B, S, H * dh)


def moba_attention(q, k, v, rel_tab_h):
    B, S, H, dh = q.shape
    G, R = KV_HEADS, GROUP
    L = MOBA_BLOCK
    dt = q.dtype
    scale = HEAD_DIM ** -0.5
    nb = max(-(-S // L), 2)
    pad = nb * L - S
    kp = jnp.pad(k, ((0, 0), (0, pad), (0, 0), (0, 0)))
    vp = jnp.pad(v, ((0, 0), (0, pad), (0, 0), (0, 0)))
    head_grp = jnp.arange(H) // R
    kb = kp.reshape(B, nb, L, G, dh)
    k_mean = jnp.mean(kb.astype(jnp.float32), axis=2).astype(dt)[:, :, head_grp]
    kbh = kb[:, :, :, head_grp].transpose(0, 3, 1, 2, 4)
    vbh = vp.reshape(B, nb, L, G, dh)[:, :, :, head_grp].transpose(0, 3, 1, 2, 4)
    top = min(MOBA_TOP, nb - 1)
    bi = jnp.arange(B)[:, None, None, None]
    hi = jnp.arange(H)[None, None, :, None]
    Qc = MOBA_Q_CHUNK

    def chunk(n):
        t0 = n * Qc
        tq = t0 + jnp.arange(Qc)
        qc = lax.dynamic_slice_in_dim(q, t0, Qc, axis=1)
        own = t0 // L
        gs = jnp.einsum('bqhd,bnhd->bqhn', qc, k_mean).astype(jnp.float32)
        gs = jnp.where(jnp.arange(nb) < own, gs, NEG)
        _, sel = lax.top_k(gs, top)
        sel_ok = sel < own
        ks = kbh[bi, hi, sel]
        vs = vbh[bi, hi, sel]
        pos = sel[..., None] * L + jnp.arange(L)
        s_past = jnp.einsum('bqhd,bqhnld->bqhnl', qc, ks) * scale
        s_past = s_past + rel_tab_h[rel_bucket(tq[None, :, None, None, None] - pos), hi[..., None]]
        k_own = lax.dynamic_slice_in_dim(kp, own * L, L, axis=1)[:, :, head_grp]
        v_own = lax.dynamic_slice_in_dim(vp, own * L, L, axis=1)[:, :, head_grp]
        dist_own = tq[:, None] - (own * L + jnp.arange(L))[None, :]
        s_own = jnp.einsum('bqhd,blhd->bqhl', qc, k_own) * scale
        s_own = s_own + rel_tab_h[rel_bucket(dist_own)].transpose(0, 2, 1)
        s = jnp.concatenate([s_past.reshape(B, Qc, H, top * L), s_own], axis=-1)
        valid = jnp.concatenate([
            jnp.broadcast_to(sel_ok[..., None], (B, Qc, H, top, L)).reshape(B, Qc, H, top * L),
            jnp.broadcast_to((dist_own >= 0)[:, None, :], (B, Qc, H, L))], axis=-1)
        p = masked_softmax(s, valid).astype(dt)
        o = (jnp.einsum('bqhk,bqhkd->bqhd', p[..., :top * L], vs.reshape(B, Qc, H, top * L, dh))
             + jnp.einsum('bqhl,blhd->bqhd', p[..., top * L:], v_own))
        return o.reshape(B, Qc, H * dh)

    out = lax.map(chunk, jnp.arange(S // Qc))
    return out.transpose(1, 0, 2, 3).reshape(B, S, H * dh)


def stick_breaking_attention(q, k, v):
    B, S, H, dh = q.shape
    dt = q.dtype
    scale = HEAD_DIM ** -0.5
    kpos = jnp.arange(S)

    def block(n):
        t0 = n * Q_BLOCK
        tq = t0 + jnp.arange(Q_BLOCK)
        qb = lax.dynamic_slice_in_dim(q, t0, Q_BLOCK, axis=1)
        z = jnp.einsum('bqhd,bkhd->bhqk', qb, k).astype(jnp.float32) * scale
        strict = kpos[None, :] < tq[:, None]
        log_1m = jnp.where(strict, jax.nn.log_sigmoid(-z), 0.0)
        after = lax.cumsum(log_1m, axis=3, reverse=True) - log_1m
        w = jnp.where(strict, jnp.exp(jax.nn.log_sigmoid(z) + after), 0.0)
        o = jnp.einsum('bhqk,bkhd->bqhd', w.astype(dt), v)
        return o.reshape(B, Q_BLOCK, H * dh)

    out = lax.map(block, jnp.arange(S // Q_BLOCK))
    return out.transpose(1, 0, 2, 3).reshape(B, S, H * dh)


def mixer_ab(h, w_in, w_out, cmp_wk, cmp_wv, cmp_pe, sinks, rel_table):
    B, S, _ = h.shape
    H, G, dh = HEADS_PER_MIXER, KV_HEADS, HEAD_DIM
    proj = h @ w_in
    sizes = [HQ, KVW, KVW, KVW, KVW, KVW, KVW, 3 * H, HQ, KVW, KVW]
    qa, kca, vca, ksa, vsa, kwa, vwa, ga, qb, kb, vb = jnp.split(proj, np.cumsum(sizes)[:-1].tolist(), axis=-1)
    kv = lambda t: t.reshape(B, S, G, dh)
    gates = jax.nn.sigmoid(ga.astype(jnp.float32)).astype(h.dtype).reshape(B, S, H, 3)
    tab_a = rel_table[:, :H].reshape(REL_BUCKETS, G, GROUP)
    tab_b = rel_table[:, H:2 * H].reshape(REL_BUCKETS, G, GROUP)
    o_a = nsa_attention(qa.reshape(B, S, H, dh), kv(kca), kv(vca), kv(ksa), kv(vsa), kv(kwa), kv(vwa),
                        gates, cmp_wk, cmp_wv, cmp_pe, tab_a)
    o_b = swa_sink_attention(qb.reshape(B, S, H, dh), kv(kb), kv(vb), sinks, tab_b)
    return jnp.concatenate([o_a, o_b], axis=-1) @ w_out


def mixer_cd(h, w_in, w_out, rel_table):
    B, S, _ = h.shape
    H, G, dh = HEADS_PER_MIXER, KV_HEADS, HEAD_DIM
    proj = h @ w_in
    sizes = [HQ, KVW, KVW, HQ, HQ, HQ]
    qc, kc, vc, qd, kd, vd = jnp.split(proj, np.cumsum(sizes)[:-1].tolist(), axis=-1)
    o_c = moba_attention(qc.reshape(B, S, H, dh), kc.reshape(B, S, G, dh), vc.reshape(B, S, G, dh),
                         rel_table[:, :H])
    o_d = stick_breaking_attention(qd.reshape(B, S, H, dh), kd.reshape(B, S, H, dh), vd.reshape(B, S, H, dh))
    return jnp.concatenate([o_c, o_d], axis=-1) @ w_out


def swiglu(h, w_in, w_out):
    gate, up = jnp.split(h @ w_in, 2, axis=-1)
    return (jax.nn.silu(gate) * up) @ w_out


def setup_inputs(seed: int = 0) -> dict:
    key = jax.random.key(seed)
    ks = jax.random.split(key, 16)
    f32 = jnp.float32

    def nrm(k, shape, s):
        return jax.random.normal(k, shape, f32) * s

    return {
        "x": nrm(ks[0], (BATCH, SEQ, D_MODEL), 1.0),
        "c": nrm(ks[1], (BATCH, D_MODEL), 1.0),
        "rel_table": nrm(ks[2], (REL_BUCKETS, N_HEAD_SLOTS), 0.5),
        "mod_w": nrm(ks[3], (DEPTH, 2, D_MODEL, 3 * D_MODEL), 0.5 * D_MODEL ** -0.5),
        "mod_b": nrm(ks[4], (DEPTH, 2, 3 * D_MODEL), 0.02),
        "norm_w": 1.0 + nrm(ks[5], (DEPTH, 2, 2, D_MODEL), 0.02),
        "w_in_ab": nrm(ks[6], (N_EVEN, D_MODEL, AB_WIDTH), D_MODEL ** -0.5),
        "w_out_ab": nrm(ks[7], (N_EVEN, MIX_WIDTH, D_MODEL), MIX_WIDTH ** -0.5),
        "nsa_cmp_wk": nrm(ks[8], (N_EVEN, NSA_CMP_LEN, HEAD_DIM, HEAD_DIM), (NSA_CMP_LEN * HEAD_DIM) ** -0.5),
        "nsa_cmp_wv": nrm(ks[9], (N_EVEN, NSA_CMP_LEN, HEAD_DIM, HEAD_DIM), (NSA_CMP_LEN * HEAD_DIM) ** -0.5),
        "nsa_cmp_pe": nrm(ks[10], (N_EVEN, NSA_CMP_LEN, HEAD_DIM), 0.1),
        "swa_sinks": nrm(ks[11], (N_EVEN, HEADS_PER_MIXER), 0.5),
        "w_in_cd": nrm(ks[12], (N_ODD, D_MODEL, CD_WIDTH), D_MODEL ** -0.5),
        "w_out_cd": nrm(ks[13], (N_ODD, MIX_WIDTH, D_MODEL), MIX_WIDTH ** -0.5),
        "ffn_w_in": nrm(ks[14], (DEPTH, D_MODEL, 2 * D_FF), D_MODEL ** -0.5),
        "ffn_w_out": nrm(ks[15], (DEPTH, D_FF, D_MODEL), D_FF ** -0.5),
    }


def reference(x, c, rel_table, mod_w, mod_b, norm_w, w_in_ab, w_out_ab, nsa_cmp_wk, nsa_cmp_wv,
              nsa_cmp_pe, swa_sinks, w_in_cd, w_out_cd, ffn_w_in, ffn_w_out):
    for layer in range(DEPTH):
        shift, scale, gate = jnp.split((c @ mod_w[layer, 0] + mod_b[layer, 0])[:, None, :], 3, axis=-1)
        h = rms_norm(x, norm_w[layer, 0, 0]) * (1.0 + scale) + shift
        i = layer // 2
        if layer % 2 == 0:
            y = mixer_ab(h, w_in_ab[i], w_out_ab[i], nsa_cmp_wk[i], nsa_cmp_wv[i], nsa_cmp_pe[i],
                         swa_sinks[i], rel_table)
        else:
            y = mixer_cd(h, w_in_cd[i], w_out_cd[i], rel_table)
        x = x + gate * rms_norm(y, norm_w[layer, 0, 1])
        shift, scale, gate = jnp.split((c @ mod_w[layer, 1] + mod_b[layer, 1])[:, None, :], 3, axis=-1)
        h = rms_norm(x, norm_w[layer, 1, 0]) * (1.0 + scale) + shift
        y = swiglu(h, ffn_w_in[layer], ffn_w_out[layer])
        x = x + gate * rms_norm(y, norm_w[layer, 1, 1])
    return x
```

```cpp
#include <hip/hip_runtime.h>
#include <hip/hip_cooperative_groups.h>
#include <cstdint>
#include <cstdio>
namespace cg = cooperative_groups;
#ifndef ZM
#define ZM 0
#endif
#ifndef NV
#define NV 0
#endif
#ifndef NVF
#define NVF 3
#endif
#ifndef NBR
#define NBR 7
#endif
#ifndef PH
#define PH 0xFFFF
#endif

#define LAS __attribute__((address_space(3)))
typedef _Float16 half_t;
typedef _Float16 h8 __attribute__((ext_vector_type(8)));
typedef _Float16 h4 __attribute__((ext_vector_type(4)));
typedef _Float16 h2 __attribute__((ext_vector_type(2)));
typedef float f32x16 __attribute__((ext_vector_type(16)));
typedef float f32x4 __attribute__((ext_vector_type(4)));
typedef float f32x2 __attribute__((ext_vector_type(2)));
typedef unsigned u32x4 __attribute__((ext_vector_type(4)));
typedef unsigned u32x2 __attribute__((ext_vector_type(2)));
typedef short s16x4 __attribute__((ext_vector_type(4)));
typedef LAS unsigned char* ldsp;
typedef const LAS unsigned char* cldsp;

constexpr int NB = 8, SEQ = 4096, DM = 1024, NT = NB * SEQ;
constexpr int NPROJ = 2304, DFF = 2816, NFF = 2 * DFF;
constexpr float LOG2E = 1.4426950408889634f;
constexpr float QSCALE = 0.125f * LOG2E;
constexpr float RMS_EPS = 1e-6f;
constexpr float NEG_INF = -__builtin_inff();

constexpr int AB_QA = 0, AB_KC = 512, AB_VC = 640, AB_KS = 768, AB_VS = 896, AB_KW = 1024, AB_VW = 1152, AB_QB = 1280, AB_KB = 1792, AB_VB = 1920;
constexpr int CD_QC = 0, CD_KC = 512, CD_VC = 640, CD_QD = 768, CD_KD = 1280, CD_VD = 1792;

constexpr size_t MiB = 1u << 20;
constexpr size_t WS_MODV = 1 * MiB;
constexpr size_t WS_CBIAS = 1 * MiB + 512 * 1024;
constexpr size_t WS_WKT = 2 * MiB;
constexpr size_t WS_WVT = 2 * MiB + 256 * 1024;
constexpr size_t WS_KCMP = 3 * MiB;
constexpr size_t WS_VCMP = 3 * MiB + 512 * 1024;
constexpr size_t WS_KM = 4 * MiB;
constexpr size_t WS_WGT = 4 * MiB + 64 * 1024;
constexpr size_t WS_GATE = 5 * MiB;
constexpr size_t WS_WAB = 8 * MiB;
constexpr size_t WS_WOAB = 13 * MiB;
constexpr size_t WS_WCD = 15 * MiB;
constexpr size_t WS_WOCD = 20 * MiB;
constexpr size_t WS_WFI = 22 * MiB;
constexpr size_t WS_WFO = 44 * MiB;
constexpr size_t WS_H = 64 * MiB;
constexpr size_t WS_PROJ = 128 * MiB;
constexpr size_t WS_ATT = 272 * MiB;
constexpr size_t WS_HID = 128 * MiB;
constexpr size_t WS_Y = 336 * MiB;
constexpr size_t WS_END = 464 * MiB;

constexpr int GRID = 256;
constexpr int RING_BYTES = 131072;
constexpr int LDS_BYTES = 163840;
constexpr int KP = 144;
constexpr int BT = 256;
constexpr int L_K0 = 0, L_K1 = 9216, L_V0 = 18432, L_V1 = 26624, L_BIAS = 34816, L_IMP = 43008, L_SEL = 59392, L_FLAG = 59904, L_KC = 60160, L_VC = 97024, L_ACC = 129792;
static_assert(L_BIAS + 8 * BT * 4 <= L_IMP && L_VC + 32768 <= L_ACC && L_ACC + 32768 <= LDS_BYTES, "lds map");

__device__ const unsigned char kBucket[128] = {
    0, 1, 2, 3, 4, 5, 6, 7, 8, 9, 10, 11, 12, 13, 14, 15, 16, 16, 16, 17, 17, 18, 18, 18, 19, 19, 19, 20, 20, 20, 20, 21, 21, 21, 21, 22, 22, 22, 22, 22, 23, 23, 23, 23, 23, 23, 24, 24, 24, 24, 24, 24,
    25, 25, 25, 25, 25, 25, 25, 26, 26, 26, 26, 26, 26, 26, 26, 27, 27, 27, 27, 27, 27, 27, 27, 27, 27, 28, 28, 28, 28, 28, 28, 28, 28, 28, 28, 29, 29, 29, 29, 29, 29, 29, 29, 29, 29, 29, 29,
    30, 30, 30, 30, 30, 30, 30, 30, 30, 30, 30, 30, 30, 30, 31, 31, 31, 31, 31, 31, 31, 31, 31, 31, 31, 31, 31, 31, 31};

namespace pg8 {
constexpr int BM = 256, BK = 64, HALF = 128, HTB = HALF * BK * 2, STAGE_BYTES = 8 * HTB, NXCD = 8, WGM = 8;
__host__ __device__ __forceinline__ int lds_byte(int r, int c) { const int st = (r >> 4) * 2 + (c >> 5), rr = r & 15, cc = c & 31, ob = rr * 64 + cc * 2; return st * 1024 + (ob ^ (((ob >> 9) & 1) << 5)); }
__host__ __device__ __forceinline__ void stage_rc(int b, int& R, int& C) { const int st = b / 1024, sb = b % 1024, swz = sb ^ (((sb >> 9) & 1) << 5); R = (st >> 1) * 16 + swz / 64; C = (st & 1) * 32 + (swz % 64) / 2; }
__host__ __device__ __forceinline__ int perm32(int rho) { const int n = rho >> 4, i = rho & 15; return 8 * (i >> 2) + 4 * n + (i & 3); }
struct Unit { int pm, pn; };
struct Gemm { const half_t* A; const half_t* Bt; int M, N, K; };
struct StaticOrder {
    int nM, nN, nwg, G, c;
    __device__ void init(int M, int N, int G_, int c_) { nM = M / BM; nN = N / BM; nwg = nM * nN; G = G_; c = c_; }
    __device__ bool next(int i, Unit& u) const {
        const long L = (long)i * G + c; if (L >= nwg) return false;
        int wgid = (int)L; { const int q = nwg / NXCD, r = nwg % NXCD, xcd = wgid % NXCD, off = wgid / NXCD; wgid = (xcd < r ? xcd * (q + 1) : r * (q + 1) + (xcd - r) * q) + off; }
        const int nig = WGM * nN, gid = wgid / nig, fm = gid * WGM, gsz = (nM - fm) < WGM ? (nM - fm) : WGM;
        u.pm = fm + ((wgid % nig) % gsz); u.pn = (wgid % nig) / gsz; return true;
    }
};

__device__ __forceinline__ unsigned pkh(float lo, float hi) { h2 v; v.x = (half_t)lo; v.y = (half_t)hi; return __builtin_bit_cast(unsigned, v); }

struct EpiProj {
    static constexpr bool PERM = true;
    half_t* O; int ldc; unsigned scale_mask;
    __device__ __forceinline__ void operator()(const f32x4 (&acc)[2][2][4][2], const Unit& u, int wr, int wc, int fr, int fq) const {
        const int row0 = u.pm * BM + wr * 64 + fr, col0 = u.pn * BM + wc * 32 + 8 * fq;
        const float sc = ((scale_mask >> u.pn) & 1u) ? QSCALE : 1.0f;
#pragma unroll
        for (int ai = 0; ai < 2; ++ai)
#pragma unroll
            for (int m = 0; m < 4; ++m) { half_t* rowp = O + (size_t)(row0 + ai * HALF + m * 16) * ldc + col0;
#pragma unroll
                for (int bj = 0; bj < 2; ++bj) { const f32x4 v0 = acc[ai][bj][m][0] * sc, v1 = acc[ai][bj][m][1] * sc;
                    u32x4 w; w.x = pkh(v0[0], v0[1]); w.y = pkh(v0[2], v0[3]); w.z = pkh(v1[0], v1[1]); w.w = pkh(v1[2], v1[3]);
                    *(u32x4*)(rowp + bj * HALF) = w; } }
    }
};
struct EpiSwiGLU {
    static constexpr bool PERM = true;
    half_t* O; int ldc;
    __device__ __forceinline__ void operator()(const f32x4 (&acc)[2][2][4][2], const Unit& u, int wr, int wc, int fr, int fq) const {
        const int row0 = u.pm * BM + wr * 64 + fr, col0 = u.pn * HALF + wc * 32 + 8 * fq;
#pragma unroll
        for (int ai = 0; ai < 2; ++ai)
#pragma unroll
            for (int m = 0; m < 4; ++m) { half_t* rowp = O + (size_t)(row0 + ai * HALF + m * 16) * ldc + col0; float r[8];
#pragma unroll
                for (int n = 0; n < 2; ++n)
#pragma unroll
                    for (int e = 0; e < 4; ++e) { const float gv = acc[ai][0][m][n][e], uv = acc[ai][1][m][n][e];
                        r[n * 4 + e] = gv * __builtin_amdgcn_rcpf(1.0f + __builtin_amdgcn_exp2f(-LOG2E * gv)) * uv; }
                u32x4 w; w.x = pkh(r[0], r[1]); w.y = pkh(r[2], r[3]); w.z = pkh(r[4], r[5]); w.w = pkh(r[6], r[7]);
                *(u32x4*)rowp = w; }
    }
};
struct EpiF32 {
    static constexpr bool PERM = false;
    float* O; int ldc;
    __device__ __forceinline__ void operator()(const f32x4 (&acc)[2][2][4][2], const Unit& u, int wr, int wc, int fr, int fq) const {
        const int row0 = u.pm * BM + wr * 64 + fr, col0 = u.pn * BM + wc * 32 + 4 * fq;
#pragma unroll
        for (int ai = 0; ai < 2; ++ai)
#pragma unroll
            for (int m = 0; m < 4; ++m) { float* rowp = O + (size_t)(row0 + ai * HALF + m * 16) * ldc + col0;
#pragma unroll
                for (int bj = 0; bj < 2; ++bj)
#pragma unroll
                    for (int n = 0; n < 2; ++n) *(f32x4*)(rowp + bj * HALF + n * 16) = acc[ai][bj][m][n]; }
    }
};

template <class Epi, class Sched, bool ALIGN_EPI>
__device__ __forceinline__ void gemm_phase(ldsp lds, const int tid, const Gemm g, const Sched& S, const Epi& E) {
    const int wid = __builtin_amdgcn_readfirstlane(tid >> 6), lane = tid & 63, wr = wid >> 2, wc = wid & 3, fr = lane & 15, fq = lane >> 4;
    const int K = g.K, nt = K / BK;
    unsigned voffA[2], voffB[2];
#pragma unroll
    for (int i = 0; i < 2; ++i) { int R, C; stage_rc(tid * 16 + i * 8192, R, C); const int Rb = Epi::PERM ? ((R & ~31) + perm32(R & 31)) : R;
        voffA[i] = (unsigned)(R * K + C) * 2u; voffB[i] = (unsigned)(Rb * K + C) * 2u; }
    const size_t kstep = (size_t)(BK * 2);
    const size_t hstep = (size_t)HALF * K * 2;
    const size_t tstep = 2 * hstep;
    const unsigned ldsw = (unsigned)wid * 1024u;
    const int aoff = lds_byte(wr * 64 + fr, fq * 8), boff = lds_byte(wc * 32 + fr, fq * 8);
#define PG8_SA(b, h) (((b) * 2 + (h)) * HTB)
#define PG8_SB(b, h) ((4 + (b) * 2 + (h)) * HTB)
#define PG8_STAGE(bufoff, gbase, voff) do { _Pragma("unroll") for (int _i = 0; _i < 2; ++_i) \
        __builtin_amdgcn_global_load_lds((const unsigned*)((const char*)(gbase) + (voff)[_i]), (LAS unsigned*)(lds + (bufoff) + ldsw + _i * 8192), 16, 0, 0); } while (0)
#define PG8_LDA(dst, b, h) do { _Pragma("unroll") for (int m = 0; m < 4; ++m) _Pragma("unroll") for (int k = 0; k < 2; ++k) dst[m][k] = *(const LAS h8*)(lds + PG8_SA(b, h) + aoff + m * 2048 + k * 1024); } while (0)
#define PG8_LDB(dst, b, h) do { _Pragma("unroll") for (int n = 0; n < 2; ++n) _Pragma("unroll") for (int k = 0; k < 2; ++k) dst[n][k] = *(const LAS h8*)(lds + PG8_SB(b, h) + boff + n * 2048 + k * 1024); } while (0)
#define PG8_MMA(ai, bj, At, Bt) do { __builtin_amdgcn_s_setprio(1); _Pragma("unroll") for (int m = 0; m < 4; ++m) _Pragma("unroll") for (int n = 0; n < 2; ++n) _Pragma("unroll") for (int k = 0; k < 2; ++k) \
        acc[ai][bj][m][n] = __builtin_amdgcn_mfma_f32_16x16x32_f16(Bt[n][k], At[m][k], acc[ai][bj][m][n], 0, 0, 0); __builtin_amdgcn_s_setprio(0); } while (0)
#define PG8_WAIT_V(n) asm volatile("s_waitcnt vmcnt(" #n ")" ::: "memory")
#define PG8_WAIT_L(n) asm volatile("s_waitcnt lgkmcnt(" #n ")" ::: "memory")
#define PG8_BAR __builtin_amdgcn_s_barrier()
#define PG8_SCHED __builtin_amdgcn_sched_barrier(0)
    Unit cur, nxt; int ui = 0;
    if (!S.next(0, cur)) return;
    f32x4 acc[2][2][4][2];
#pragma unroll
    for (int a = 0; a < 2; ++a)
#pragma unroll
        for (int b = 0; b < 2; ++b)
#pragma unroll
            for (int m = 0; m < 4; ++m)
#pragma unroll
                for (int n = 0; n < 2; ++n) acc[a][b][m][n] = (f32x4){0.f, 0.f, 0.f, 0.f};
    h8 At[4][2], B0[2][2], B1[2][2];
    const char* cA = (const char*)g.A + (size_t)cur.pm * tstep; const char* cB = (const char*)g.Bt + (size_t)cur.pn * tstep;
    PG8_STAGE(PG8_SB(0, 0), cB, voffB); PG8_STAGE(PG8_SB(0, 1), cB + hstep, voffB); PG8_STAGE(PG8_SA(0, 0), cA, voffA); PG8_STAGE(PG8_SA(0, 1), cA + hstep, voffA);
    if (wr == 1) PG8_BAR;
    PG8_WAIT_V(2); PG8_BAR;
    PG8_STAGE(PG8_SB(1, 0), cB + kstep, voffB); PG8_STAGE(PG8_SA(1, 0), cA + kstep, voffA); PG8_STAGE(PG8_SB(1, 1), cB + hstep + kstep, voffB);
    PG8_WAIT_V(6); PG8_BAR;
    for (;;) {
        const bool has_next = S.next(ui + 1, nxt);
        const char* nA = has_next ? (const char*)g.A + (size_t)nxt.pm * tstep : cA; const char* nB = has_next ? (const char*)g.Bt + (size_t)nxt.pn * tstep : cB;
        for (int t = 0; t < nt; t += 2) {
            const bool last = (t == nt - 2);
            const char* a1 = cA + (size_t)(t + 1) * kstep;
            const char* a2 = last ? nA : cA + (size_t)(t + 2) * kstep; const char* b2 = last ? nB : cB + (size_t)(t + 2) * kstep;
            const char* a3 = a2 + kstep; const char* b3 = b2 + kstep;
            PG8_LDB(B0, 0, 0); PG8_LDB(B1, 0, 1); PG8_SCHED; PG8_LDA(At, 0, 0); PG8_STAGE(PG8_SA(1, 1), a1 + hstep, voffA);
            PG8_WAIT_V(8); PG8_WAIT_L(0); PG8_BAR; PG8_MMA(0, 0, At, B0); PG8_MMA(0, 1, At, B1); PG8_BAR; PG8_SCHED;
            PG8_LDA(At, 0, 1); PG8_STAGE(PG8_SB(0, 0), b2, voffB); PG8_STAGE(PG8_SB(0, 1), b2 + hstep, voffB); PG8_STAGE(PG8_SA(0, 0), a2, voffA);
            PG8_WAIT_V(8); PG8_WAIT_L(0); PG8_BAR; PG8_MMA(1, 0, At, B0); PG8_MMA(1, 1, At, B1); PG8_BAR; PG8_SCHED;
            PG8_LDB(B0, 1, 0); PG8_LDB(B1, 1, 1); PG8_SCHED; PG8_LDA(At, 1, 0); PG8_STAGE(PG8_SA(0, 1), a2 + hstep, voffA);
            PG8_WAIT_V(8); PG8_WAIT_L(0); PG8_BAR; PG8_MMA(0, 0, At, B0); PG8_MMA(0, 1, At, B1); PG8_BAR; PG8_SCHED;
            PG8_LDA(At, 1, 1); PG8_STAGE(PG8_SB(1, 0), b3, voffB); PG8_STAGE(PG8_SB(1, 1), b3 + hstep, voffB); PG8_STAGE(PG8_SA(1, 0), a3, voffA);
            PG8_WAIT_V(8); PG8_WAIT_L(0); PG8_BAR; PG8_MMA(1, 0, At, B0); PG8_MMA(1, 1, At, B1); PG8_BAR; PG8_SCHED;
        }
        if constexpr (ALIGN_EPI) { if (wr == 0) PG8_BAR; }
        E(acc, cur, wr, wc, fr, fq);
        if (!has_next) break;
#pragma unroll
        for (int a = 0; a < 2; ++a)
#pragma unroll
            for (int b = 0; b < 2; ++b)
#pragma unroll
                for (int m = 0; m < 4; ++m)
#pragma unroll
                    for (int n = 0; n < 2; ++n) acc[a][b][m][n] = (f32x4){0.f, 0.f, 0.f, 0.f};
        cur = nxt; cA = nA; cB = nB; ++ui;
        if constexpr (ALIGN_EPI) { if (wr == 1) PG8_BAR; }
    }
    PG8_WAIT_V(0);
    if constexpr (!ALIGN_EPI) { if (wr == 0) PG8_BAR; }
    PG8_BAR;
#undef PG8_SA
#undef PG8_SB
#undef PG8_STAGE
#undef PG8_LDA
#undef PG8_LDB
#undef PG8_MMA
#undef PG8_WAIT_V
#undef PG8_WAIT_L
#undef PG8_BAR
#undef PG8_SCHED
}
}

struct Args {
    const float* x; const float* c; const float* rel; const float* mod_w; const float* mod_b; const float* norm_w;
    const float* w_in_ab; const float* w_out_ab; const float* cmp_wk; const float* cmp_wv; const float* cmp_pe; const float* sinks;
    const float* w_in_cd; const float* w_out_cd; const float* ffn_w_in; const float* ffn_w_out;
    float* out; unsigned char* ws;
};

struct Ctx {
    ldsp L; int tid, lane, wave, G, vcu;
};

__device__ __forceinline__ float wave_sum(float v) {
#pragma unroll
    for (int o = 1; o < 64; o <<= 1) v += __shfl_xor(v, o);
    return v;
}

template <int MAP> __device__ __forceinline__ int src_col(int n) {
    if (MAP == 1) { return n < 1280 ? n : n + 24; }
    if (MAP == 2) { const int j = n & 255, pn = n >> 8; return j < 128 ? 128 * pn + j : DFF + 128 * pn + (j - 128); }
    if (MAP == 3) { return n < 24 ? 1280 + n : -1; }
    return n;
}
template <int MAP> __device__ __forceinline__ void transpose_item(const float* W, int K, int Nsrc, int Ndst, half_t* WT, LAS float* scr, int item, int lane) {
    const int nblk = Ndst / 32, kb = item / nblk, nb = item % nblk, k0 = 64 * kb, n0 = 32 * nb;
    const int sc = src_col<MAP>(n0 + (lane & 31));
#pragma unroll 8
    for (int i = 0; i < 32; ++i) { const int kk = 2 * i + (lane >> 5); scr[kk * 33 + (lane & 31)] = sc >= 0 ? W[(size_t)(k0 + kk) * Nsrc + sc] : 0.f; }
    asm volatile("s_waitcnt lgkmcnt(0)" ::: "memory");
    const int c = lane & 7;
#pragma unroll
    for (int j = 0; j < 4; ++j) { const int n = (lane >> 3) + 8 * j; const LAS float* s = scr + (8 * c) * 33 + n;
        u32x4 o; o.x = pg8::pkh(s[0 * 33], s[1 * 33]); o.y = pg8::pkh(s[2 * 33], s[3 * 33]); o.z = pg8::pkh(s[4 * 33], s[5 * 33]); o.w = pg8::pkh(s[6 * 33], s[7 * 33]);
        *(u32x4*)(WT + (size_t)(n0 + n) * K + k0 + 8 * c) = o; }
    asm volatile("s_waitcnt lgkmcnt(0)" ::: "memory");
}

__device__ __forceinline__ void phase_prologue(const Ctx& X, const Args& a) {
    unsigned char* ws = a.ws;
    if (blockIdx.x < 192) {
        const int ls = blockIdx.x / 48, cgp = blockIdx.x % 48, col = cgp * 64 + X.lane;
        const float* W = a.mod_w + (size_t)ls * 1024 * 3072;
        float acc[8];
#pragma unroll
        for (int b = 0; b < 8; ++b) acc[b] = 0.f;
        const int kbeg = X.wave * 128;
#pragma unroll 4
        for (int k = kbeg; k < kbeg + 128; ++k) { const float w = W[(size_t)k * 3072 + col];
#pragma unroll
            for (int b = 0; b < 8; ++b) acc[b] += a.c[b * 1024 + k] * w; }
        LAS float* red = (LAS float*)X.L;
#pragma unroll
        for (int b = 0; b < 8; ++b) red[(X.wave * 8 + b) * 64 + X.lane] = acc[b];
        __syncthreads();
        { const int b = X.wave; float s = 0.f;
#pragma unroll
          for (int w = 0; w < 8; ++w) s += red[(w * 8 + b) * 64 + X.lane];
          s += a.mod_b[ls * 3072 + col];
          ((float*)(ws + WS_MODV))[(size_t)(ls * 8 + b) * 3072 + col] = s; }
        __syncthreads();
    } else if (blockIdx.x == 192) {
        const int tsr = X.wave & 1, kq = X.wave >> 1; const float* W = tsr ? a.cmp_wv : a.cmp_wk;
        float s = 0.f;
        for (int k = kq * 512; k < kq * 512 + 512; ++k) s += a.cmp_pe[k] * W[(size_t)k * 64 + X.lane];
        LAS float* red = (LAS float*)X.L;
        red[X.wave * 64 + X.lane] = s;
        __syncthreads();
        if (X.wave < 2) { const float t = red[X.wave * 64 + X.lane] + red[(X.wave + 2) * 64 + X.lane] + red[(X.wave + 4) * 64 + X.lane] + red[(X.wave + 6) * 64 + X.lane];
            ((float*)(ws + WS_CBIAS))[X.wave * 64 + X.lane] = t; }
        __syncthreads();
    }
    LAS float* scr = (LAS float*)(X.L + 32768 + X.wave * 8704);
    const int gw = X.vcu * 8 + X.wave, NGW = X.G * 8;
    constexpr int I_AB = 16 * (2048 / 32), I_CD = 16 * (NPROJ / 32), I_O = 16 * 32, I_FI = 16 * (NFF / 32), I_FO = (DFF / 64) * 32, I_C = 32 * 2, I_G = 16;
    constexpr int NITEMS = I_AB + I_CD + 2 * I_O + 2 * I_FI + 2 * I_FO + 2 * I_C + I_G;
    for (int it = gw; it < NITEMS; it += NGW) {
        int r = it;
        if (r < I_AB) { transpose_item<1>(a.w_in_ab, 1024, 2072, 2048, (half_t*)(ws + WS_WAB), scr, r, X.lane); continue; } r -= I_AB;
        if (r < I_CD) { transpose_item<0>(a.w_in_cd, 1024, 2304, NPROJ, (half_t*)(ws + WS_WCD), scr, r, X.lane); continue; } r -= I_CD;
        if (r < I_O) { transpose_item<0>(a.w_out_ab, 1024, 1024, 1024, (half_t*)(ws + WS_WOAB), scr, r, X.lane); continue; } r -= I_O;
        if (r < I_O) { transpose_item<0>(a.w_out_cd, 1024, 1024, 1024, (half_t*)(ws + WS_WOCD), scr, r, X.lane); continue; } r -= I_O;
        if (r < 2 * I_FI) { const int l = r / I_FI; transpose_item<2>(a.ffn_w_in + (size_t)l * 1024 * NFF, 1024, NFF, NFF, (half_t*)(ws + WS_WFI) + (size_t)l * NFF * 1024, scr, r % I_FI, X.lane); continue; } r -= 2 * I_FI;
        if (r < 2 * I_FO) { const int l = r / I_FO; transpose_item<0>(a.ffn_w_out + (size_t)l * DFF * 1024, DFF, 1024, 1024, (half_t*)(ws + WS_WFO) + (size_t)l * 1024 * DFF, scr, r % I_FO, X.lane); continue; } r -= 2 * I_FO;
        if (r < I_C) { transpose_item<0>(a.cmp_wk, 2048, 64, 64, (half_t*)(ws + WS_WKT), scr, r, X.lane); continue; } r -= I_C;
        if (r < I_C) { transpose_item<0>(a.cmp_wv, 2048, 64, 64, (half_t*)(ws + WS_WVT), scr, r, X.lane); continue; } r -= I_C;
        transpose_item<3>(a.w_in_ab, 1024, 2072, 32, (half_t*)(ws + WS_WGT), scr, r, X.lane);
    }
}

__device__ __forceinline__ void rows_phase(const Ctx& X, bool has_y, bool do_h, const float* xin, const float* y, float* xo, half_t* H,
                                           const float* wpost, const float* mvpost, const float* wpre, const float* mvpre) {
    const int gw = X.vcu * 8 + X.wave, NGW = X.G * 8, lane = X.lane;
    for (int row = gw; row < NT; row += NGW) {
        const int b = row >> 12;
        f32x4 v[4];
#pragma unroll
        for (int j = 0; j < 4; ++j) v[j] = *(const f32x4*)(xin + (size_t)row * DM + 4 * lane + 256 * j);
        if (has_y) {
            f32x4 yv[4]; float ss = 0.f;
#pragma unroll
            for (int j = 0; j < 4; ++j) { yv[j] = *(const f32x4*)(y + (size_t)row * DM + 4 * lane + 256 * j); ss += (yv[j].x * yv[j].x + yv[j].y * yv[j].y) + (yv[j].z * yv[j].z + yv[j].w * yv[j].w); }
            const float rinv = 1.0f / sqrtf(wave_sum(ss) * (1.0f / DM) + RMS_EPS);
#pragma unroll
            for (int j = 0; j < 4; ++j) { const f32x4 w = *(const f32x4*)(wpost + 4 * lane + 256 * j); const f32x4 gt = *(const f32x4*)(mvpost + (size_t)b * 3072 + 2048 + 4 * lane + 256 * j);
                v[j] = v[j] + gt * (yv[j] * rinv * w); *(f32x4*)(xo + (size_t)row * DM + 4 * lane + 256 * j) = v[j]; }
        }
        if (do_h) {
            float ss = 0.f;
#pragma unroll
            for (int j = 0; j < 4; ++j) ss += (v[j].x * v[j].x + v[j].y * v[j].y) + (v[j].z * v[j].z + v[j].w * v[j].w);
            const float rinv = 1.0f / sqrtf(wave_sum(ss) * (1.0f / DM) + RMS_EPS);
#pragma unroll
            for (int j = 0; j < 4; ++j) { const f32x4 w = *(const f32x4*)(wpre + 4 * lane + 256 * j);
                const f32x4 sh = *(const f32x4*)(mvpre + (size_t)b * 3072 + 4 * lane + 256 * j), sc = *(const f32x4*)(mvpre + (size_t)b * 3072 + 1024 + 4 * lane + 256 * j);
                const f32x4 hv = (v[j] * rinv * w) * (1.0f + sc) + sh;
                u32x2 o; o.x = pg8::pkh(hv.x, hv.y); o.y = pg8::pkh(hv.z, hv.w);
                *(u32x2*)(H + (size_t)row * DM + 4 * lane + 256 * j) = o; }
        }
    }
}

__device__ __forceinline__ float xh_max(float v) { auto rr = __builtin_amdgcn_permlane32_swap(__float_as_uint(v), __float_as_uint(v), false, false); return fmaxf(__uint_as_float(rr[0]), __uint_as_float(rr[1])); }
__device__ __forceinline__ float xh_sum(float v) { auto rr = __builtin_amdgcn_permlane32_swap(__float_as_uint(v), __float_as_uint(v), false, false); return __uint_as_float(rr[0]) + __uint_as_float(rr[1]); }
__device__ __forceinline__ float xh_get(float v, int h) { auto rr = __builtin_amdgcn_permlane32_swap(__float_as_uint(v), __float_as_uint(v), false, false); return h ? __uint_as_float(rr[0]) : __uint_as_float(rr[1]); }
__device__ __forceinline__ float quad_sum(float v) {
    v += __int_as_float(__builtin_amdgcn_update_dpp(0, __float_as_int(v), 0xB1, 0xf, 0xf, false));
    v += __int_as_float(__builtin_amdgcn_update_dpp(0, __float_as_int(v), 0x4E, 0xf, 0xf, false));
    return v;
}
__device__ __forceinline__ unsigned pk_rtz(float a, float b) { return __builtin_bit_cast(unsigned, __builtin_amdgcn_cvt_pkrtz(a, b)); }
__device__ __forceinline__ int krow(int r, int h) { return (r & 3) + 8 * (r >> 2) + 4 * h; }

__device__ __forceinline__ void qk64(f32x16& s0, f32x16& s1, cldsp kb, const h8 (&qf)[4], float init, int r, int h) {
#pragma unroll
    for (int i = 0; i < 16; ++i) { s0[i] = init; s1[i] = init; }
    cldsp p = kb + r * KP + h * 16;
#pragma unroll
    for (int kd = 0; kd < 4; ++kd) {
        const h8 a0 = *(const LAS h8*)(p + kd * 32), a1 = *(const LAS h8*)(p + 32 * KP + kd * 32);
        s0 = __builtin_amdgcn_mfma_f32_32x32x16_f16(a0, qf[kd], s0, 0, 0, 0);
        s1 = __builtin_amdgcn_mfma_f32_32x32x16_f16(a1, qf[kd], s1, 0, 0, 0);
    }
}
__device__ __forceinline__ void qk32(f32x16& s0, cldsp kb, const h8 (&qf)[4], int r, int h) {
#pragma unroll
    for (int i = 0; i < 16; ++i) s0[i] = 0.f;
    cldsp p = kb + r * KP + h * 16;
#pragma unroll
    for (int kd = 0; kd < 4; ++kd) { const h8 a0 = *(const LAS h8*)(p + kd * 32); s0 = __builtin_amdgcn_mfma_f32_32x32x16_f16(a0, qf[kd], s0, 0, 0, 0); }
}
__device__ __forceinline__ void pv64(f32x16& o0, f32x16& o1, cldsp vb, int dstride, const f32x16& p0, const f32x16& p1, int lane) {
    const int h = lane >> 5, q = (lane & 15) >> 2, p = lane & 3, gb = (lane >> 4) & 1;
    cldsp base = vb + (4 * h + q) * 64 + (16 * gb + 4 * p) * 2;
#pragma unroll
    for (int ks = 0; ks < 4; ++ks) {
        const f32x16& P = (ks < 2) ? p0 : p1; const int rb = 8 * (ks & 1);
        u32x4 w; w.x = pk_rtz(P[rb + 0], P[rb + 1]); w.y = pk_rtz(P[rb + 2], P[rb + 3]); w.z = pk_rtz(P[rb + 4], P[rb + 5]); w.w = pk_rtz(P[rb + 6], P[rb + 7]);
        const h8 pb = __builtin_bit_cast(h8, w);
#pragma unroll
        for (int dh = 0; dh < 2; ++dh) {
            const s16x4 lo = __builtin_amdgcn_ds_read_tr16_b64_v4i16((LAS s16x4*)(base + dh * dstride + (16 * ks) * 64));
            const s16x4 hi = __builtin_amdgcn_ds_read_tr16_b64_v4i16((LAS s16x4*)(base + dh * dstride + (16 * ks + 8) * 64));
            typedef short s16x8 __attribute__((ext_vector_type(8)));
            const s16x8 av = __builtin_shufflevector(lo, hi, 0, 1, 2, 3, 4, 5, 6, 7);
            const h8 a = __builtin_bit_cast(h8, av);
            if (dh == 0) o0 = __builtin_amdgcn_mfma_f32_32x32x16_f16(a, pb, o0, 0, 0, 0);
            else o1 = __builtin_amdgcn_mfma_f32_32x32x16_f16(a, pb, o1, 0, 0, 0);
        }
    }
}
template <bool WITH_O> __device__ __forceinline__ void softmax_step(f32x16& s0, f32x16& s1, float& m, float& l, f32x16& o0, f32x16& o1) {
    float mx = fmaxf(s0[0], s1[0]);
#pragma unroll
    for (int i = 1; i < 16; ++i) mx = fmaxf(mx, fmaxf(s0[i], s1[i]));
    mx = xh_max(mx);
    const float mn = fmaxf(m, mx), mu = (mn == NEG_INF) ? 0.f : mn;
    const float alpha = __builtin_amdgcn_exp2f(m - mu);
    float sum = 0.f;
#pragma unroll
    for (int i = 0; i < 16; ++i) { s0[i] = __builtin_amdgcn_exp2f(s0[i] - mu); s1[i] = __builtin_amdgcn_exp2f(s1[i] - mu); sum += s0[i] + s1[i]; }
    l = l * alpha + sum; m = mn;
    if (WITH_O) { if (__any(alpha != 1.0f)) { o0 *= alpha; o1 *= alpha; } }
}
__device__ __forceinline__ void tile_load(u32x4& kr, u32x4& vr, const half_t* Kg, const half_t* Vg, size_t pitch, int tid) {
    const int key = tid >> 3, ch = tid & 7;
    kr = *(const u32x4*)(Kg + (size_t)key * pitch + ch * 8); vr = *(const u32x4*)(Vg + (size_t)key * pitch + ch * 8);
}
__device__ __forceinline__ void tile_store(ldsp kb, ldsp vb, const u32x4& kr, const u32x4& vr, int tid) {
    const int key = tid >> 3, ch = tid & 7;
    *(LAS u32x4*)(kb + key * KP + ch * 16) = kr; *(LAS u32x4*)(vb + (ch >> 2) * 4096 + key * 64 + (ch & 3) * 16) = vr;
}
__device__ __forceinline__ void build_bias(const Ctx& X, const float* rel, int sb) {
    LAS float* bt = (LAS float*)(X.L + L_BIAS);
    for (int i = X.tid; i < 8 * BT; i += 512) { const int hs = i / BT, d = i % BT - 64; bt[i] = d < 0 ? 0.f : rel[(int)kBucket[min(d, 127)] * 16 + sb + hs] * LOG2E; }
    __syncthreads();
}
template <int WIN> __device__ __forceinline__ void mask_near(f32x16& s0, f32x16& s1, const LAS float* btl, int Dl, bool mine) {
#pragma unroll
    for (int i = 0; i < 16; ++i) { const int c0 = (i & 3) + 8 * (i >> 2), c1 = c0 + 32;
        const float b0 = btl[59 - c0], b1 = btl[59 - c1];
        const bool v0 = mine && Dl >= c0 && (WIN >= 8192 || Dl < WIN + c0), v1 = mine && Dl >= c1 && (WIN >= 8192 || Dl < WIN + c1);
        s0[i] = v0 ? s0[i] + b0 : NEG_INF; s1[i] = v1 ? s1[i] + b1 : NEG_INF; }
}
__device__ __forceinline__ void store_col(half_t* dst, const f32x16& o0, const f32x16& o1, float sc, int h) {
#pragma unroll
    for (int dh = 0; dh < 2; ++dh)
#pragma unroll
        for (int gi = 0; gi < 4; ++gi) { const f32x16& o = dh ? o1 : o0;
            u32x2 w; w.x = pg8::pkh(o[4 * gi] * sc, o[4 * gi + 1] * sc); w.y = pg8::pkh(o[4 * gi + 2] * sc, o[4 * gi + 3] * sc);
            *(u32x2*)(dst + 32 * dh + 8 * gi + 4 * h) = w; }
}

__device__ __forceinline__ void acc_set(LAS unsigned* accL, const f32x16& o0, const f32x16& o1, float sc) {
#pragma unroll
    for (int i = 0; i < 8; ++i) { accL[i * 512] = pg8::pkh(o0[2 * i] * sc, o0[2 * i + 1] * sc); accL[(8 + i) * 512] = pg8::pkh(o1[2 * i] * sc, o1[2 * i + 1] * sc); }
}
__device__ __forceinline__ void acc_add(LAS unsigned* accL, const f32x16& o0, const f32x16& o1, float sc) {
#pragma unroll
    for (int i = 0; i < 8; ++i) { const h2 p0 = __builtin_bit_cast(h2, accL[i * 512]), p1 = __builtin_bit_cast(h2, accL[(8 + i) * 512]);
        accL[i * 512] = pg8::pkh((float)p0.x + o0[2 * i] * sc, (float)p0.y + o0[2 * i + 1] * sc); accL[(8 + i) * 512] = pg8::pkh((float)p1.x + o1[2 * i] * sc, (float)p1.y + o1[2 * i + 1] * sc); }
}
__device__ __forceinline__ void acc_store(half_t* dst, const LAS unsigned* accL, const f32x16& o0, const f32x16& o1, float sc, bool add_old) {
#pragma unroll
    for (int dh = 0; dh < 2; ++dh)
#pragma unroll
        for (int gi = 0; gi < 4; ++gi) { const f32x16& o = dh ? o1 : o0;
            const h2 p0 = __builtin_bit_cast(h2, accL[(8 * dh + 2 * gi) * 512]), p1 = __builtin_bit_cast(h2, accL[(8 * dh + 2 * gi + 1) * 512]);
            float v0 = (float)p0.x + o[4 * gi] * sc, v1 = (float)p0.y + o[4 * gi + 1] * sc, v2 = (float)p1.x + o[4 * gi + 2] * sc, v3 = (float)p1.y + o[4 * gi + 3] * sc;
            if (add_old) { const u32x2 old = *(const u32x2*)(dst + 32 * dh + 8 * gi); const h2 a0 = __builtin_bit_cast(h2, old.x), a1 = __builtin_bit_cast(h2, old.y);
                v0 += (float)a0.x; v1 += (float)a0.y; v2 += (float)a1.x; v3 += (float)a1.y; }
            u32x2 w; w.x = pg8::pkh(v0, v1); w.y = pg8::pkh(v2, v3);
            *(u32x2*)(dst + 32 * dh + 8 * gi) = w; }
}

template <int WIN> __device__ __forceinline__ void banded_attn(const Ctx& X, const half_t* Kg, const half_t* Vg, int t0, const h8 (&qf)[4], int tq, int hs,
                                                               float m_init, float l_init, f32x16& o0, f32x16& o1, float& l_out) {
    const int lane = X.lane, r = lane & 31, h = lane >> 5;
    const LAS float* bt = (const LAS float*)(X.L + L_BIAS) + hs * BT;
    const float bfar = bt[64 + 127];
    float m = m_init, l = l_init;
#pragma unroll
    for (int i = 0; i < 16; ++i) { o0[i] = 0.f; o1[i] = 0.f; }
    int kfirst = t0 - WIN; if (kfirst < 0) kfirst = 0;
    const int ntile = (t0 - kfirst) / 64 + 1;
    u32x4 kr, vr;
    tile_load(kr, vr, Kg + (size_t)kfirst * NPROJ, Vg + (size_t)kfirst * NPROJ, NPROJ, X.tid);
#pragma unroll 1
    for (int i = 0; i < ntile; ++i) {
        const int k0 = kfirst + 64 * i; const int buf = i & 1;
        ldsp kb = X.L + (buf ? L_K1 : L_K0), vb = X.L + (buf ? L_V1 : L_V0);
        tile_store(kb, vb, kr, vr, X.tid);
        __syncthreads();
        if (i + 1 < ntile) tile_load(kr, vr, Kg + (size_t)(k0 + 64) * NPROJ, Vg + (size_t)(k0 + 64) * NPROJ, NPROJ, X.tid);
        f32x16 s0, s1;
        const int Dl = tq - k0 - 4 * h;
        if (k0 >= t0 - 128) { qk64(s0, s1, kb, qf, 0.f, r, h); mask_near<WIN>(s0, s1, bt + (Dl + 5), Dl, true); }
        else { qk64(s0, s1, kb, qf, bfar, r, h);
            if (WIN > 128 && k0 == t0 - WIN) {
#pragma unroll
                for (int i2 = 0; i2 < 16; ++i2) { const int c0 = (i2 & 3) + 8 * (i2 >> 2), c1 = c0 + 32; s0[i2] = (Dl < WIN + c0) ? s0[i2] : NEG_INF; s1[i2] = (Dl < WIN + c1) ? s1[i2] : NEG_INF; } } }
        softmax_step<true>(s0, s1, m, l, o0, o1);
        pv64(o0, o1, vb, 4096, s0, s1, lane);
    }
    __syncthreads();
    l_out = xh_sum(l);
}

__device__ __forceinline__ void gate_job(const Ctx& X, const Args& a, int tile32) {
    const int lane = X.lane, r = lane & 31, h = lane >> 5;
    const half_t* Hrow = (const half_t*)(a.ws + WS_H) + (size_t)(32 * tile32 + r) * DM + 8 * h;
    const half_t* Wrow = (const half_t*)(a.ws + WS_WGT) + (size_t)r * DM + 8 * h;
    f32x16 c;
#pragma unroll
    for (int i = 0; i < 16; ++i) c[i] = 0.f;
#pragma unroll 8
    for (int ks = 0; ks < 64; ++ks) { const h8 av = *(const h8*)(Wrow + 16 * ks), bv = *(const h8*)(Hrow + 16 * ks); c = __builtin_amdgcn_mfma_f32_32x32x16_f16(av, bv, c, 0, 0, 0); }
    half_t* dst = (half_t*)(a.ws + WS_GATE) + (size_t)(32 * tile32 + r) * 32;
#pragma unroll
    for (int gi = 0; gi < 4; ++gi) { float s[4];
#pragma unroll
        for (int k = 0; k < 4; ++k) s[k] = __builtin_amdgcn_rcpf(1.0f + __builtin_amdgcn_exp2f(-LOG2E * c[4 * gi + k]));
        u32x2 w; w.x = pg8::pkh(s[0], s[1]); w.y = pg8::pkh(s[2], s[3]);
        *(u32x2*)(dst + 8 * gi + 4 * h) = w; }
}

__device__ __forceinline__ void swa_unit(const Ctx& X, const Args& a, int b, int g, int tile) {
    const int lane = X.lane, r = lane & 31, h = lane >> 5, hd = r & 3, head = 4 * g + hd, tq = 64 * tile + 8 * X.wave + (r >> 2);
    const half_t* P = (const half_t*)(a.ws + WS_PROJ) + (size_t)b * SEQ * NPROJ;
    const half_t* prow = P + (size_t)tq * NPROJ;
    h8 qf[4];
#pragma unroll
    for (int kd = 0; kd < 4; ++kd) qf[kd] = *(const h8*)(prow + AB_QB + head * 64 + 16 * kd + 8 * h);
    const float sink2 = a.sinks[head] * LOG2E;
    f32x16 o0, o1; float l;
    banded_attn<128>(X, P + AB_KB + g * 64, P + AB_VB + g * 64, 64 * tile, qf, tq, head, sink2, h == 0 ? 1.0f : 0.0f, o0, o1, l);
    half_t* dst = (half_t*)(a.ws + WS_ATT) + ((size_t)b * SEQ + tq) * DM + 512 + head * 64;
    store_col(dst, o0, o1, (ZM & 2) ? 0.f : 1.0f / l, h);
}

__device__ __forceinline__ void compress_job(const Ctx& X, const Args& a, int job) {
    const int ntile = job & 7, tsr = (job >> 3) & 1, g = (job >> 4) & 1, b = job >> 5;
    const int lane = X.lane, r = lane & 31, h = lane >> 5;
    const half_t* P = (const half_t*)(a.ws + WS_PROJ) + (size_t)b * SEQ * NPROJ + (tsr ? AB_VC : AB_KC) + g * 64;
    const half_t* WT = (const half_t*)(a.ws + (tsr ? WS_WVT : WS_WKT));
    const int n = 32 * ntile + r;
    f32x16 c0, c1;
#pragma unroll
    for (int i = 0; i < 16; ++i) { c0[i] = 0.f; c1[i] = 0.f; }
#pragma unroll 4
    for (int ks = X.wave * 16; ks < X.wave * 16 + 16; ++ks) {
        const int kk0 = 16 * ks, l = kk0 >> 6, d0 = kk0 & 63;
        const int tok = min(16 * n + l, SEQ - 1);
        const h8 av = *(const h8*)(P + (size_t)tok * NPROJ + d0 + 8 * h);
        const h8 b0 = *(const h8*)(WT + (size_t)r * 2048 + kk0 + 8 * h), b1 = *(const h8*)(WT + (size_t)(32 + r) * 2048 + kk0 + 8 * h);
        c0 = __builtin_amdgcn_mfma_f32_32x32x16_f16(av, b0, c0, 0, 0, 0);
        c1 = __builtin_amdgcn_mfma_f32_32x32x16_f16(av, b1, c1, 0, 0, 0);
    }
    LAS float* red = (LAS float*)X.L + X.wave * 2048;
#pragma unroll
    for (int i = 0; i < 16; ++i) { red[krow(i, h) * 64 + r] = c0[i]; red[krow(i, h) * 64 + 32 + r] = c1[i]; }
    __syncthreads();
    const float* cb = (const float*)(a.ws + WS_CBIAS) + tsr * 64;
    half_t* dst = (half_t*)(a.ws + (tsr ? WS_VCMP : WS_KCMP)) + ((size_t)(b * 2 + g) * 256 + 32 * ntile) * 64;
    for (int i = X.tid; i < 2048; i += 512) { float s = 0.f;
#pragma unroll
        for (int w = 0; w < 8; ++w) s += ((const LAS float*)X.L)[w * 2048 + i];
        dst[i] = (half_t)(s + cb[i & 63]); }
    __syncthreads();
}

__device__ __forceinline__ void nsa_unit(const Ctx& X, const Args& a, int b, int g, int tile) {
    const int lane = X.lane, r = lane & 31, h = lane >> 5, hd = r & 3, head = 4 * g + hd, tokl = 8 * X.wave + (r >> 2), t0 = 64 * tile, tq = t0 + tokl, own = tile;
    const half_t* P = (const half_t*)(a.ws + WS_PROJ) + (size_t)b * SEQ * NPROJ;
    const half_t* prow = P + (size_t)tq * NPROJ;
    h8 qf[4];
#pragma unroll
    for (int kd = 0; kd < 4; ++kd) qf[kd] = *(const h8*)(prow + AB_QA + head * 64 + 16 * kd + 8 * h);
    const half_t* grow = (const half_t*)(a.ws + WS_GATE) + ((size_t)b * SEQ + tq) * 32 + head * 3;
    const float g_c = (float)grow[0], g_s = (float)grow[1], g_w = (float)grow[2];
    const LAS float* bt = (const LAS float*)(X.L + L_BIAS) + head * BT;
    half_t* const dst = (half_t*)(a.ws + WS_ATT) + ((size_t)b * SEQ + tq) * DM + head * 64 + 4 * h;
    LAS unsigned* const accp = (LAS unsigned*)(X.L + L_ACC) + X.tid;
    {
        const int ncv = min(255, t0 / 16 + 3), nct = (ncv + 63) >> 6;
        const half_t* KCg = (const half_t*)(a.ws + WS_KCMP) + (size_t)(b * 2 + g) * 256 * 64;
        const half_t* VCg = (const half_t*)(a.ws + WS_VCMP) + (size_t)(b * 2 + g) * 256 * 64;
        for (int i = X.tid; i < nct * 512; i += 512) { const int key = i >> 3, ch = i & 7;
            const u32x4 kv = *(const u32x4*)(KCg + key * 64 + ch * 8), vv = *(const u32x4*)(VCg + key * 64 + ch * 8);
            *(LAS u32x4*)(X.L + L_KC + key * KP + ch * 16) = kv; *(LAS u32x4*)(X.L + L_VC + (ch >> 2) * 16384 + key * 64 + (ch & 3) * 16) = vv; }
        __syncthreads();
        float m = NEG_INF, l = 0.f; f32x16 o0, o1;
#pragma unroll
        for (int i = 0; i < 16; ++i) { o0[i] = 0.f; o1[i] = 0.f; }
#pragma unroll 1
        for (int ct = 0; ct < nct; ++ct) {
            f32x16 s0, s1; qk64(s0, s1, X.L + L_KC + ct * 64 * KP, qf, 0.f, r, h);
#pragma unroll
            for (int i = 0; i < 16; ++i) { const int d0 = tq - (16 * (64 * ct + krow(i, h)) + 31), d1 = d0 - 512;
                s0[i] = d0 >= 0 ? s0[i] + bt[64 + min(d0, 127)] : NEG_INF; s1[i] = d1 >= 0 ? s1[i] + bt[64 + min(d1, 127)] : NEG_INF; }
            softmax_step<false>(s0, s1, m, l, o0, o1);
        }
        l = xh_sum(l);
        const float inv = l > 0.f ? 1.0f / l : 0.f, mu = (m == NEG_INF) ? 0.f : m;
        LAS float* impL = (LAS float*)(X.L + L_IMP) + tokl * 64;
        float carry = 0.f;
#pragma unroll 1
        for (int ct = 0; ct < nct; ++ct) {
            f32x16 s0, s1; qk64(s0, s1, X.L + L_KC + ct * 64 * KP, qf, 0.f, r, h);
#pragma unroll
            for (int i = 0; i < 16; ++i) { const int d0 = tq - (16 * (64 * ct + krow(i, h)) + 31), d1 = d0 - 512;
                s0[i] = d0 >= 0 ? __builtin_amdgcn_exp2f(s0[i] + bt[64 + min(d0, 127)] - mu) * inv : 0.f;
                s1[i] = d1 >= 0 ? __builtin_amdgcn_exp2f(s1[i] + bt[64 + min(d1, 127)] - mu) * inv : 0.f; }
#pragma unroll
            for (int hf = 0; hf < 2; ++hf) {
                const f32x16& pp = hf ? s1 : s0; const int ht = 2 * ct + hf;
                float A[4], Eo[4], Xp[4];
#pragma unroll
                for (int gi = 0; gi < 4; ++gi) { Eo[gi] = 0.5f * pp[4 * gi + 3]; A[gi] = (pp[4 * gi] + pp[4 * gi + 1]) + (pp[4 * gi + 2] + Eo[gi]); }
#pragma unroll
                for (int gi = 0; gi < 4; ++gi) Xp[gi] = xh_get(Eo[gi], h);
#pragma unroll
                for (int gi = 0; gi < 4; ++gi) { const float recv = h ? Xp[gi] : (gi == 0 ? carry : Xp[gi > 0 ? gi - 1 : 0]);
                    const float v = quad_sum(A[gi] + recv);
                    if (hd == 0) impL[8 * ht + 2 * gi + h] = v; }
                carry = Xp[3];
            }
            pv64(o0, o1, X.L + L_VC + ct * 64 * 64, 16384, s0, s1, lane);
        }
        acc_set(accp, o0, o1, ((ZM & 1) || !(NBR & 1)) ? 0.f : g_c);
    }
    unsigned long long umask = 0ull, mymask;
    {
        LAS unsigned long long* selL = (LAS unsigned long long*)(X.L + L_SEL);
        const bool causal = lane <= own, forced = (lane == 0) || (lane == own) || (lane == own - 1);
#pragma unroll 1
        for (int tk = 0; tk < 8; ++tk) {
            const float v = ((const LAS float*)(X.L + L_IMP))[(8 * X.wave + tk) * 64 + lane];
            const float key = causal ? (v + (forced ? 1e4f : 0.f)) : -1e30f;
            int cnt = 0;
#pragma unroll 8
            for (int j = 0; j < 64; ++j) { const float kj = __int_as_float(__builtin_amdgcn_readlane(__float_as_int(key), j)); cnt += ((kj > key) || (kj == key && j < lane)) ? 1 : 0; }
            const unsigned long long mk = __ballot((cnt < 8) && causal);
            if (lane == 0) selL[8 * X.wave + tk] = mk;
            umask |= mk;
        }
        mymask = selL[tokl];
    }
    {
        const half_t* Kg = P + AB_KS + g * 64; const half_t* Vg = P + AB_VS + g * 64;
        float m = NEG_INF, l = 0.f; f32x16 o0, o1;
#pragma unroll
        for (int i = 0; i < 16; ++i) { o0[i] = 0.f; o1[i] = 0.f; }
        u32x4 kr, vr; tile_load(kr, vr, Kg, Vg, NPROJ, X.tid);
#pragma unroll 1
        for (int s = 0; s <= own; ++s) {
            const int buf = s & 1; ldsp kb = X.L + (buf ? L_K1 : L_K0), vb = X.L + (buf ? L_V1 : L_V0);
            tile_store(kb, vb, kr, vr, X.tid);
            __syncthreads();
            if (s + 1 <= own) tile_load(kr, vr, Kg + (size_t)(64 * s + 64) * NPROJ, Vg + (size_t)(64 * s + 64) * NPROJ, NPROJ, X.tid);
            if ((umask >> s) & 1ull) {
                f32x16 s0, s1;
                const bool mine = (mymask >> s) & 1ull; const int Dl = tq - 64 * s - 4 * h;
                if (s >= own - 2) { qk64(s0, s1, kb, qf, 0.f, r, h); mask_near<8192>(s0, s1, bt + (Dl + 5), Dl, mine); }
                else qk64(s0, s1, kb, qf, mine ? bt[64 + 127] : NEG_INF, r, h);
                softmax_step<true>(s0, s1, m, l, o0, o1);
                pv64(o0, o1, vb, 4096, s0, s1, lane);
            }
        }
        __syncthreads();
        l = xh_sum(l); const float sc = ((ZM & 1) || !(NBR & 2)) ? 0.f : g_s / l;
        acc_add(accp, o0, o1, sc);
    }
    {
        f32x16 o0, o1; float l;
        banded_attn<512>(X, P + AB_KW + g * 64, P + AB_VW + g * 64, t0, qf, tq, head, NEG_INF, 0.f, o0, o1, l);
        const float sc = ((ZM & 1) || !(NBR & 4)) ? 0.f : g_w / l;
        acc_store(dst, accp, o0, o1, sc, NBR != 7);
    }
}

__device__ __forceinline__ void kmean_job(const Ctx& X, const Args& a, int job) {
    const int j = job & 15, g = (job >> 4) & 1, b = job >> 5, key = X.tid >> 3, ch = X.tid & 7;
    const half_t* Kg = (const half_t*)(a.ws + WS_PROJ) + ((size_t)b * SEQ + 256 * j) * NPROJ + CD_KC + g * 64;
    float s[8];
#pragma unroll
    for (int e = 0; e < 8; ++e) s[e] = 0.f;
#pragma unroll
    for (int it = 0; it < 4; ++it) { const h8 v = *(const h8*)(Kg + (size_t)(key + 64 * it) * NPROJ + ch * 8);
#pragma unroll
        for (int e = 0; e < 8; ++e) s[e] += (float)v[e]; }
    LAS float* red = (LAS float*)X.L;
#pragma unroll
    for (int e = 0; e < 8; ++e) red[key * 64 + ch * 8 + e] = s[e];
    __syncthreads();
    if (X.tid < 64) { float t = 0.f;
        for (int k = 0; k < 64; ++k) t += red[k * 64 + X.tid];
        t *= (1.0f / 16.0f);
        const half_t hi = (half_t)t, lo = (half_t)(t - (float)hi);
        half_t* dst = (half_t*)(a.ws + WS_KM) + (size_t)(b * 2 + g) * 32 * 64;
        dst[j * 64 + X.tid] = hi; dst[(16 + j) * 64 + X.tid] = lo; }
    __syncthreads();
}

__device__ __forceinline__ void moba_unit(const Ctx& X, const Args& a, int b, int g, int tile) {
    const int lane = X.lane, r = lane & 31, h = lane >> 5, hd = r & 3, head = 4 * g + hd, t0 = 64 * tile, tq = t0 + 8 * X.wave + (r >> 2), ownb = tile >> 2;
    const half_t* P = (const half_t*)(a.ws + WS_PROJ) + (size_t)b * SEQ * NPROJ;
    const half_t* prow = P + (size_t)tq * NPROJ;
    h8 qf[4];
#pragma unroll
    for (int kd = 0; kd < 4; ++kd) qf[kd] = *(const h8*)(prow + CD_QC + head * 64 + 16 * kd + 8 * h);
    const LAS float* bt = (const LAS float*)(X.L + L_BIAS) + head * BT;
    unsigned sel16 = 0u;
    {
        const half_t* KMg = (const half_t*)(a.ws + WS_KM) + (size_t)(b * 2 + g) * 32 * 64;
        if (X.tid < 256) { const int key = X.tid >> 3, ch = X.tid & 7; *(LAS u32x4*)(X.L + L_K0 + key * KP + ch * 16) = *(const u32x4*)(KMg + key * 64 + ch * 8); }
        __syncthreads();
        f32x16 sg; qk32(sg, X.L + L_K0, qf, r, h);
        float gsv[16];
#pragma unroll
        for (int i = 0; i < 8; ++i) { const float mine = sg[i] + sg[i + 8], other = xh_get(mine, h); const int jl = (i & 3) + 8 * (i >> 2);
            gsv[jl] = h ? other : mine; gsv[jl + 4] = h ? mine : other; }
#pragma unroll
        for (int rep = 0; rep < 3; ++rep) { float best = NEG_INF; int bi = -1;
#pragma unroll
            for (int j = 0; j < 16; ++j) { const bool ok = (j < ownb) && !((sel16 >> j) & 1u); if (ok && gsv[j] > best) { best = gsv[j]; bi = j; } }
            if (bi >= 0) sel16 |= 1u << bi; }
        __syncthreads();
    }
    unsigned umask = 0u;
#pragma unroll
    for (int j = 0; j < 16; ++j) if (__ballot((sel16 >> j) & 1u) != 0ull) umask |= 1u << j;
    const half_t* Kg = P + CD_KC + g * 64; const half_t* Vg = P + CD_VC + g * 64;
    float m = NEG_INF, l = 0.f; f32x16 o0, o1;
#pragma unroll
    for (int i = 0; i < 16; ++i) { o0[i] = 0.f; o1[i] = 0.f; }
    u32x4 kr, vr; tile_load(kr, vr, Kg, Vg, NPROJ, X.tid);
    for (int kt = 0; kt <= tile; ++kt) {
        const int buf = kt & 1; ldsp kb = X.L + (buf ? L_K1 : L_K0), vb = X.L + (buf ? L_V1 : L_V0);
        tile_store(kb, vb, kr, vr, X.tid);
        __syncthreads();
        if (kt + 1 <= tile) tile_load(kr, vr, Kg + (size_t)(64 * kt + 64) * NPROJ, Vg + (size_t)(64 * kt + 64) * NPROJ, NPROJ, X.tid);
        const int blk = kt >> 2; const bool past = blk < ownb;
        if (!past || ((umask >> blk) & 1u)) {
            f32x16 s0, s1;
            const bool mine = past ? ((sel16 >> blk) & 1u) : true; const int Dl = tq - 64 * kt - 4 * h;
            if (kt >= tile - 2) { qk64(s0, s1, kb, qf, 0.f, r, h); mask_near<8192>(s0, s1, bt + (Dl + 5), Dl, mine); }
            else qk64(s0, s1, kb, qf, mine ? bt[64 + 127] : NEG_INF, r, h);
            softmax_step<true>(s0, s1, m, l, o0, o1);
            pv64(o0, o1, vb, 4096, s0, s1, lane);
        }
    }
    __syncthreads();
    l = xh_sum(l);
    half_t* dst = (half_t*)(a.ws + WS_ATT) + ((size_t)b * SEQ + tq) * DM + head * 64;
    store_col(dst, o0, o1, (ZM & 4) ? 0.f : 1.0f / l, h);
}

__device__ __forceinline__ void stick_unit(const Ctx& X, const Args& a, int b, int head, int tile) {
    const int lane = X.lane, r = lane & 31, h = lane >> 5, t0 = 256 * tile, tq = t0 + 32 * X.wave + r;
    const half_t* P = (const half_t*)(a.ws + WS_PROJ) + (size_t)b * SEQ * NPROJ;
    const half_t* prow = P + (size_t)tq * NPROJ;
    h8 qf[4];
#pragma unroll
    for (int kd = 0; kd < 4; ++kd) qf[kd] = *(const h8*)(prow + CD_QD + head * 64 + 16 * kd + 8 * h);
    const half_t* Kg = P + CD_KD + head * 64; const half_t* Vg = P + CD_VD + head * 64;
    LAS int* flags = (LAS int*)(X.L + L_FLAG);
    if (X.tid < 16) flags[X.tid] = 0;
    f32x16 o0, o1;
#pragma unroll
    for (int i = 0; i < 16; ++i) { o0[i] = 0.f; o1[i] = 0.f; }
    float carry = 1.0f; bool done = false;
    const int kt_top = 4 * tile + 3, ktw = 4 * tile + (X.wave >> 1);
    u32x4 kr, vr; tile_load(kr, vr, Kg + (size_t)(64 * kt_top) * NPROJ, Vg + (size_t)(64 * kt_top) * NPROJ, NPROJ, X.tid);
    for (int i = 0; i <= kt_top; ++i) {
        const int kt = kt_top - i, k0 = 64 * kt, buf = i & 1; ldsp kb = X.L + (buf ? L_K1 : L_K0), vb = X.L + (buf ? L_V1 : L_V0);
        tile_store(kb, vb, kr, vr, X.tid);
        __syncthreads();
        { int alld = 1;
#pragma unroll
          for (int w = 0; w < 8; ++w) alld &= flags[((i + 1) & 1) * 8 + w];
          if (alld) break; }
        if (kt > 0) tile_load(kr, vr, Kg + (size_t)(k0 - 64) * NPROJ, Vg + (size_t)(k0 - 64) * NPROJ, NPROJ, X.tid);
        if (kt <= ktw && !done) {
            f32x16 s0, s1; qk64(s0, s1, kb, qf, 0.f, r, h);
#pragma unroll
            for (int hf = 1; hf >= 0; --hf) {
                f32x16& z = hf ? s1 : s0;
                float T[4], To[4];
#pragma unroll
                for (int gi = 0; gi < 4; ++gi) {
                    float u[4], sg[4];
#pragma unroll
                    for (int k = 0; k < 4; ++k) { const int kpos = k0 + 32 * hf + 8 * gi + 4 * h + k; const bool valid = kpos < tq;
                        const float e = __builtin_amdgcn_exp2f(z[4 * gi + k]); const float uu = __builtin_amdgcn_rcpf(1.0f + e);
                        u[k] = valid ? uu : 1.0f; sg[k] = valid ? 1.0f - uu : 0.f; }
                    const float e2 = u[3], e1 = e2 * u[2], e0 = e1 * u[1];
                    T[gi] = e0 * u[0];
                    z[4 * gi + 3] = sg[3]; z[4 * gi + 2] = sg[2] * e2; z[4 * gi + 1] = sg[1] * e1; z[4 * gi] = sg[0] * e0;
                }
#pragma unroll
                for (int gi = 0; gi < 4; ++gi) To[gi] = xh_get(T[gi], h);
                float R = carry;
#pragma unroll
                for (int gi = 3; gi >= 0; --gi) { const float Xg = h ? R : R * To[gi];
                    z[4 * gi] *= Xg; z[4 * gi + 1] *= Xg; z[4 * gi + 2] *= Xg; z[4 * gi + 3] *= Xg;
                    R *= T[gi] * To[gi]; }
                carry = R;
            }
            pv64(o0, o1, vb, 4096, s0, s1, lane);
            done = !__any(carry >= 9.0949470177e-13f);
        }
        if (lane == 0) flags[(i & 1) * 8 + X.wave] = (done || kt == 0) ? 1 : 0;
    }
    __syncthreads();
    half_t* dst = (half_t*)(a.ws + WS_ATT) + ((size_t)b * SEQ + tq) * DM + 512 + head * 64;
    store_col(dst, o0, o1, (ZM & 8) ? 0.f : 1.0f, h);
    __syncthreads();
}

__device__ __forceinline__ float bias_naive(const float* rel, int dist, int slot) { return rel[(int)kBucket[min(dist, 127)] * 16 + slot] * LOG2E; }
__device__ __forceinline__ void swa_naive(const Ctx& X, const Args& a) {
    const half_t* PR = (const half_t*)(a.ws + WS_PROJ);
    for (int item = blockIdx.x * 512 + X.tid; item < NT * 8; item += X.G * 512) {
        const int head = item & 7, row = item >> 3, t = row & (SEQ - 1), b = row >> 12, g = head >> 2;
        const half_t* prow = PR + (size_t)row * NPROJ;
        float q[64], o[64];
#pragma unroll
        for (int d = 0; d < 64; ++d) { q[d] = (float)prow[AB_QB + head * 64 + d]; o[d] = 0.f; }
        float m = a.sinks[head] * LOG2E, l = 1.f;
        for (int kp = max(0, t - 127); kp <= t; ++kp) {
            const half_t* kr = PR + ((size_t)b * SEQ + kp) * NPROJ + AB_KB + g * 64; const half_t* vr = PR + ((size_t)b * SEQ + kp) * NPROJ + AB_VB + g * 64;
            float s = 0.f;
#pragma unroll
            for (int d = 0; d < 64; ++d) s += q[d] * (float)kr[d];
            s += bias_naive(a.rel, t - kp, 8 + head);
            const float mn = fmaxf(m, s), al = exp2f(m - mn), p = exp2f(s - mn);
            l = l * al + p; m = mn;
#pragma unroll
            for (int d = 0; d < 64; ++d) o[d] = o[d] * al + p * (float)vr[d];
        }
        half_t* dst = (half_t*)(a.ws + WS_ATT) + (size_t)row * DM + 512 + head * 64;
#pragma unroll
        for (int d = 0; d < 64; ++d) dst[d] = (half_t)(o[d] / l);
    }
}
__device__ __forceinline__ void stick_naive(const Ctx& X, const Args& a) {
    const half_t* PR = (const half_t*)(a.ws + WS_PROJ);
    for (int item = blockIdx.x * 512 + X.tid; item < NT * 8; item += X.G * 512) {
        const int head = item & 7, row = item >> 3, t = row & (SEQ - 1), b = row >> 12;
        const half_t* prow = PR + (size_t)row * NPROJ;
        float q[64], o[64];
#pragma unroll
        for (int d = 0; d < 64; ++d) { q[d] = (float)prow[CD_QD + head * 64 + d]; o[d] = 0.f; }
        float carry = 1.f;
        for (int kp = t - 1; kp >= 0 && carry > 1e-30f; --kp) {
            const half_t* kr = PR + ((size_t)b * SEQ + kp) * NPROJ + CD_KD + head * 64; const half_t* vr = PR + ((size_t)b * SEQ + kp) * NPROJ + CD_VD + head * 64;
            float z = 0.f;
#pragma unroll
            for (int d = 0; d < 64; ++d) z += q[d] * (float)kr[d];
            const float e = exp2f(z), u = 1.0f / (1.0f + e), w = (1.0f - u) * carry;
            carry *= u;
#pragma unroll
            for (int d = 0; d < 64; ++d) o[d] += w * (float)vr[d];
        }
        half_t* dst = (half_t*)(a.ws + WS_ATT) + (size_t)row * DM + 512 + head * 64;
#pragma unroll
        for (int d = 0; d < 64; ++d) dst[d] = (half_t)o[d];
    }
}

__device__ __forceinline__ void moba_naive_pre(const Ctx& X, const Args& a) {
    const half_t* PR = (const half_t*)(a.ws + WS_PROJ); float* KMN = (float*)(a.ws + WS_Y) + (2u << 18);
    for (int item = blockIdx.x * 512 + X.tid; item < 8 * 16 * 2 * 64; item += X.G * 512) {
        const int d = item & 63, g = (item >> 6) & 1, j = (item >> 7) & 15, b = item >> 11;
        float s = 0.f;
        for (int k = 0; k < 256; ++k) s += (float)PR[((size_t)b * SEQ + 256 * j + k) * NPROJ + CD_KC + g * 64 + d];
        KMN[item] = s * (1.0f / 256.0f);
    }
}
__device__ __forceinline__ void moba_naive(const Ctx& X, const Args& a) {
    const half_t* PR = (const half_t*)(a.ws + WS_PROJ); const float* KMN = (const float*)(a.ws + WS_Y) + (2u << 18);
    for (int item = blockIdx.x * 512 + X.tid; item < NT * 8; item += X.G * 512) {
        const int head = item & 7, row = item >> 3, t = row & (SEQ - 1), b = row >> 12, g = head >> 2, ownb = t >> 8;
        const half_t* prow = PR + (size_t)row * NPROJ;
        float q[64], o[64];
#pragma unroll
        for (int d = 0; d < 64; ++d) { q[d] = (float)prow[CD_QC + head * 64 + d]; o[d] = 0.f; }
        unsigned sel = 0u;
        for (int rep = 0; rep < 3; ++rep) { float best = NEG_INF; int bi = -1;
            for (int j = 0; j < ownb; ++j) { if ((sel >> j) & 1u) continue; const float* km = KMN + (((size_t)b * 16 + j) * 2 + g) * 64; float s = 0.f;
#pragma unroll
                for (int d = 0; d < 64; ++d) s += q[d] * km[d];
                if (s > best) { best = s; bi = j; } }
            if (bi >= 0) sel |= 1u << bi; }
        float m = NEG_INF, l = 0.f;
        for (int j = 0; j <= ownb; ++j) {
            if (j < ownb && !((sel >> j) & 1u)) continue;
            const int kend = j < ownb ? 256 * j + 255 : t;
            for (int kp = 256 * j; kp <= kend; ++kp) {
                const half_t* kr = PR + ((size_t)b * SEQ + kp) * NPROJ + CD_KC + g * 64; const half_t* vr = PR + ((size_t)b * SEQ + kp) * NPROJ + CD_VC + g * 64;
                float s = 0.f;
#pragma unroll
                for (int d = 0; d < 64; ++d) s += q[d] * (float)kr[d];
                s += bias_naive(a.rel, t - kp, head);
                const float mn = fmaxf(m, s), al = exp2f(m - mn), p = exp2f(s - mn);
                l = l * al + p; m = mn;
#pragma unroll
                for (int d = 0; d < 64; ++d) o[d] = o[d] * al + p * (float)vr[d];
            }
        }
        half_t* dst = (half_t*)(a.ws + WS_ATT) + (size_t)row * DM + head * 64;
#pragma unroll
        for (int d = 0; d < 64; ++d) dst[d] = (half_t)(o[d] / l);
    }
}
__device__ __forceinline__ void nsa_naive_pre(const Ctx& X, const Args& a) {
    const half_t* PR = (const half_t*)(a.ws + WS_PROJ); float* KCN = (float*)(a.ws + WS_Y);
    for (int item = blockIdx.x * 512 + X.tid; item < 2 * 8 * 256 * 2 * 64; item += X.G * 512) {
        const int e = item & 63, g = (item >> 6) & 1, n = (item >> 7) & 255, b = (item >> 15) & 7, tsr = item >> 18;
        const float* W = tsr ? a.cmp_wv : a.cmp_wk; float s = 0.f;
        if (NVF & 2) { KCN[item] = (float)((const half_t*)(a.ws + (tsr ? WS_VCMP : WS_KCMP)))[((size_t)(b * 2 + g) * 256 + n) * 64 + e]; continue; }
        if (n < 255) for (int l = 0; l < 32; ++l) for (int d = 0; d < 64; ++d)
            s += ((float)PR[((size_t)b * SEQ + 16 * n + l) * NPROJ + (tsr ? AB_VC : AB_KC) + g * 64 + d] + a.cmp_pe[l * 64 + d]) * W[(l * 64 + d) * 64 + e];
        KCN[item] = s;
    }
}
__device__ __forceinline__ void nsa_naive(const Ctx& X, const Args& a) {
    const half_t* PR = (const half_t*)(a.ws + WS_PROJ); const half_t* Hh = (const half_t*)(a.ws + WS_H);
    const float* KCN = (const float*)(a.ws + WS_Y); const float* VCN = KCN + (1u << 18);
    float* IMPN = (float*)(a.ws + WS_Y) + (1u << 20);
    for (int item = blockIdx.x * 512 + X.tid; item < NT * 8; item += GRID * 512) {
        const int head = item & 7, row = item >> 3, t = row & (SEQ - 1), b = row >> 12, g = head >> 2, own = t >> 6;
        const half_t* prow = PR + (size_t)row * NPROJ;
        float* outp = a.out + (size_t)item * 64;
        const half_t* q = prow + AB_QA + head * 64;
        float gt[3];
#pragma unroll
        for (int br = 0; br < 3; ++br) { float s = 0.f;
            if (NVF & 1) { gt[br] = (float)((const half_t*)(a.ws + WS_GATE))[(size_t)row * 32 + head * 3 + br]; }
            else { for (int k = 0; k < 1024; ++k) s += (float)Hh[(size_t)row * DM + k] * a.w_in_ab[(size_t)k * 2072 + 1280 + head * 3 + br]; gt[br] = 1.0f / (1.0f + expf(-s)); } }
        const int nv = t >= 31 ? (t - 31) / 16 + 1 : 0;
        float m = NEG_INF, l = 0.f;
        for (int n = 0; n < nv; ++n) { const float* kc = KCN + ((((size_t)b * 256 + n) * 2 + g) * 64); float s = 0.f;
            for (int d = 0; d < 64; ++d) s += (float)q[d] * kc[d];
            s += bias_naive(a.rel, t - (16 * n + 31), head);
            const float mn = fmaxf(m, s); l = l * exp2f(m - mn) + exp2f(s - mn); m = mn; }
        for (int d = 0; d < 64; ++d) outp[d] = 0.f;
        for (int n = 0; n < nv; ++n) { const float* kc = KCN + ((((size_t)b * 256 + n) * 2 + g) * 64); const float* vc = VCN + ((((size_t)b * 256 + n) * 2 + g) * 64); float s = 0.f;
            for (int d = 0; d < 64; ++d) s += (float)q[d] * kc[d];
            s += bias_naive(a.rel, t - (16 * n + 31), head);
            const float p = ((NBR & 1) && NBR != 7 ? 0.f : gt[0]) * exp2f(s - m) / l;
            for (int d = 0; d < 64; ++d) outp[d] += p * vc[d]; }
        for (int s_ = 0; s_ < 64; ++s_) { float im = 0.f;
            for (int k = -1; k < 4; ++k) { const int n = 4 * s_ + k; if (n < 0 || n >= nv) continue; const float* kc = KCN + ((((size_t)b * 256 + n) * 2 + g) * 64); float s = 0.f;
                for (int d = 0; d < 64; ++d) s += (float)q[d] * kc[d];
                s += bias_naive(a.rel, t - (16 * n + 31), head);
                im += ((k == -1 || k == 3) ? 0.5f : 1.0f) * exp2f(s - m) / l; }
            im = quad_sum(im);
            IMPN[(size_t)item * 64 + s_] = im; }
        unsigned long long sel = 0ull;
        for (int rep = 0; rep < 8; ++rep) { float best = -3e38f; int bi = -1;
            for (int s_ = 0; s_ <= own; ++s_) { if ((sel >> s_) & 1ull) continue; const bool forced = s_ == 0 || s_ == own || s_ == own - 1;
                const float key = IMPN[(size_t)item * 64 + s_] + (forced ? 1e4f : 0.f); if (key > best) { best = key; bi = s_; } }
            if (bi >= 0) sel |= 1ull << bi; }
        m = NEG_INF; l = 0.f;
        for (int s_ = 0; s_ <= own; ++s_) { if (!((sel >> s_) & 1ull)) continue;
            for (int kp = 64 * s_; kp <= min(64 * s_ + 63, t); ++kp) { const half_t* kr = PR + ((size_t)b * SEQ + kp) * NPROJ + AB_KS + g * 64; float s = 0.f;
                for (int d = 0; d < 64; ++d) s += (float)q[d] * (float)kr[d];
                s += bias_naive(a.rel, t - kp, head);
                const float mn = fmaxf(m, s); l = l * exp2f(m - mn) + exp2f(s - mn); m = mn; } }
        for (int s_ = 0; s_ <= own; ++s_) { if (!((sel >> s_) & 1ull)) continue;
            for (int kp = 64 * s_; kp <= min(64 * s_ + 63, t); ++kp) { const half_t* kr = PR + ((size_t)b * SEQ + kp) * NPROJ + AB_KS + g * 64; const half_t* vr = PR + ((size_t)b * SEQ + kp) * NPROJ + AB_VS + g * 64; float s = 0.f;
                for (int d = 0; d < 64; ++d) s += (float)q[d] * (float)kr[d];
                s += bias_naive(a.rel, t - kp, head);
                const float p = ((NBR & 2) && NBR != 7 ? 0.f : gt[1]) * exp2f(s - m) / l;
                for (int d = 0; d < 64; ++d) outp[d] += p * (float)vr[d]; } }
        m = NEG_INF; l = 0.f;
        for (int kp = max(0, t - 511); kp <= t; ++kp) { const half_t* kr = PR + ((size_t)b * SEQ + kp) * NPROJ + AB_KW + g * 64; float s = 0.f;
            for (int d = 0; d < 64; ++d) s += (float)q[d] * (float)kr[d];
            s += bias_naive(a.rel, t - kp, head);
            const float mn = fmaxf(m, s); l = l * exp2f(m - mn) + exp2f(s - mn); m = mn; }
        for (int kp = max(0, t - 511); kp <= t; ++kp) { const half_t* kr = PR + ((size_t)b * SEQ + kp) * NPROJ + AB_KW + g * 64; const half_t* vr = PR + ((size_t)b * SEQ + kp) * NPROJ + AB_VW + g * 64; float s = 0.f;
            for (int d = 0; d < 64; ++d) s += (float)q[d] * (float)kr[d];
            s += bias_naive(a.rel, t - kp, head);
            const float p = ((NBR & 4) && NBR != 7 ? 0.f : gt[2]) * exp2f(s - m) / l;
            for (int d = 0; d < 64; ++d) outp[d] += p * (float)vr[d]; }
        half_t* dst = (half_t*)(a.ws + WS_ATT) + (size_t)row * DM + head * 64;
        for (int d = 0; d < 64; ++d) dst[d] = (half_t)outp[d];
    }
}

__device__ __forceinline__ void balanced_unit(int vcu, int i, int& bg, int& tile) {
    const int s = vcu & 15; bg = vcu >> 4; tile = (i == 0) ? s : (i == 1) ? 31 - s : (i == 2) ? 32 + s : 63 - s;
}

template <class Epi> __device__ __forceinline__ void run_gemm(const Ctx& X, const half_t* A, const half_t* Bt, int N, int K, const Epi& E) {
    pg8::Gemm g{A, Bt, NT, N, K}; pg8::StaticOrder S; S.init(NT, N, X.G, (int)blockIdx.x);
    pg8::gemm_phase<Epi, pg8::StaticOrder, true>(X.L, X.tid, g, S, E);
}
__device__ __forceinline__ Ctx make_ctx(ldsp L) {
    Ctx X; int t = threadIdx.x; asm volatile("" : "+v"(t));
    X.L = L; X.tid = t; X.lane = t & 63; X.wave = __builtin_amdgcn_readfirstlane(t >> 6);
    X.G = GRID; { const int bx = blockIdx.x; X.vcu = (bx % 8) * (GRID / 8) + bx / 8; }
    return X;
}

__global__ void __launch_bounds__(512, 2) fwd_kernel(Args a_in) {
    extern __shared__ __attribute__((aligned(16))) unsigned char lds_raw[];
    cg::grid_group grid = cg::this_grid();
    const ldsp L = (ldsp)lds_raw;
    for (int step = 0; step < 18; ++step) {
        Args a = a_in; { unsigned char* w_ = a_in.ws; asm volatile("" : "+s"(w_)); a.ws = w_; }
        unsigned char* ws = a.ws;
        const float* modv = (const float*)(ws + WS_MODV);
        const int layer = step < 2 ? 0 : (step - 2) >> 3, q = step < 2 ? step - 2 : (step - 2) & 7;
        const Ctx X = make_ctx(L);
        half_t* H = (half_t*)(ws + WS_H); half_t* PROJ = (half_t*)(ws + WS_PROJ); half_t* ATT = (half_t*)(ws + WS_ATT); half_t* HID = (half_t*)(ws + WS_HID); float* Y = (float*)(ws + WS_Y);
        if (q == -2) { if (PH & 1) phase_prologue(X, a); }
        else if (q == -1 || q == 4 || q == 7) {
            const bool has_y = q >= 0, do_h = !(q == 7 && layer == 1);
            const int ls_post = layer * 2 + (q == 7 ? 1 : 0), ls_pre = q == -1 ? 0 : (q == 4 ? layer * 2 + 1 : 2);
            const float* xin = (q == -1 || (q == 4 && layer == 0)) ? a.x : a.out;
            if (PH & 2) rows_phase(X, has_y, do_h, xin, Y, a.out, H, a.norm_w + (size_t)(ls_post * 2 + 1) * 1024, modv + (size_t)ls_post * 8 * 3072,
                       a.norm_w + (size_t)(ls_pre * 2 + 0) * 1024, modv + (size_t)ls_pre * 8 * 3072);
        }
        else if (q == 0) {
            pg8::EpiProj E{PROJ, NPROJ, layer == 0 ? 0x63u : 0x1Bu};
            if (PH & 4) run_gemm(X, H, (const half_t*)(ws + (layer == 0 ? WS_WAB : WS_WCD)), layer == 0 ? 2048 : NPROJ, 1024, E);
        }
        else if (q == 1) {
            if (layer == 0) {
                if (PH & 8) for (int j = X.vcu * 8 + X.wave; j < 1024; j += X.G * 8) gate_job(X, a, j);
                if (PH & 16) for (int j = X.vcu; j < 256; j += X.G) compress_job(X, a, j);
                build_bias(X, a.rel, 8);
                if (NV & 2) swa_naive(X, a); else
                if (PH & 32) for (int u = X.vcu; u < 1024; u += X.G) swa_unit(X, a, u >> 7, (u >> 6) & 1, u & 63);
            } else {
                if (PH & 64) for (int j = X.vcu; j < 256; j += X.G) kmean_job(X, a, j);
                if (NV & 4) moba_naive_pre(X, a);
                if (NV & 8) stick_naive(X, a); else
                if (PH & 128) for (int u = X.vcu; u < 1024; u += X.G) stick_unit(X, a, u >> 7, (u >> 4) & 7, u & 15);
            }
        }
        else if (q == 2) {
            build_bias(X, a.rel, 0);
            if (layer == 0 && (NV & 1)) { nsa_naive_pre(X, a); grid.sync(); nsa_naive(X, a); if (NBR != 7) grid.sync(); }
            if (layer == 1 && (NV & 4)) moba_naive(X, a);
            else if (layer == 0) { if (!(NV & 1) || NBR != 7) { for (int i = 0; i < 1024; i += X.G) { const int u = i + X.vcu; if (u < 1024) { int bg, tile; balanced_unit(u & 255, u >> 8, bg, tile); if (PH & 256) nsa_unit(X, a, bg >> 1, bg & 1, tile); } } } }
            else            { for (int i = 0; i < 1024; i += X.G) { const int u = i + X.vcu; if (u < 1024) { int bg, tile; balanced_unit(u & 255, u >> 8, bg, tile); if (PH & 512) moba_unit(X, a, bg >> 1, bg & 1, tile); } } }
        }
        else if (q == 3 || q == 6) {
            pg8::EpiF32 E{Y, DM};
            const half_t* Aop = q == 3 ? ATT : HID;
            const half_t* Bop = q == 3 ? (const half_t*)(ws + (layer == 0 ? WS_WOAB : WS_WOCD)) : (const half_t*)(ws + WS_WFO) + (size_t)layer * 1024 * DFF;
            if (PH & 1024) run_gemm(X, Aop, Bop, DM, q == 3 ? 1024 : DFF, E);
        }
        else {
            pg8::EpiSwiGLU E{HID, DFF}; if (PH & 2048) run_gemm(X, H, (const half_t*)(ws + WS_WFI) + (size_t)layer * NFF * 1024, NFF, 1024, E);
        }
        if (step != 17) grid.sync();
    }
}

extern "C" void kernel_launch(void* const* d_in, const int* in_sizes, int n_in, void* d_out, int out_size, void* d_ws, size_t ws_size, hipStream_t stream) {
    static int grid = 0;
    if (grid == 0) {
        if (n_in != 16 || out_size != NT * DM || ws_size < WS_END) { fprintf(stderr, "kernel_launch: unexpected problem (n_in %d out %d ws %zu)\n", n_in, out_size, ws_size); grid = -1; return; }
        int dev = 0, cus = 0, per_cu = 0;
        hipGetDevice(&dev); hipDeviceGetAttribute(&cus, hipDeviceAttributeMultiprocessorCount, dev);
        hipFuncSetAttribute((const void*)fwd_kernel, hipFuncAttributeMaxDynamicSharedMemorySize, LDS_BYTES);
        hipOccupancyMaxActiveBlocksPerMultiprocessor(&per_cu, (const void*)fwd_kernel, 512, LDS_BYTES);
        if (per_cu < 1) { fprintf(stderr, "kernel_launch: occupancy query says %d blocks per CU\n", per_cu); per_cu = 1; }
        if (cus * per_cu < GRID) { fprintf(stderr, "kernel_launch: device holds %d x %d workgroups, kernel built for %d\n", cus, per_cu, GRID); grid = -1; return; }
        grid = GRID;
        (void)hipGetLastError();
    }
    if (grid < 0) return;
    Args a{};
    a.x = (const float*)d_in[0]; a.c = (const float*)d_in[1]; a.rel = (const float*)d_in[2]; a.mod_w = (const float*)d_in[3]; a.mod_b = (const float*)d_in[4]; a.norm_w = (const float*)d_in[5];
    a.w_in_ab = (const float*)d_in[6]; a.w_out_ab = (const float*)d_in[7]; a.cmp_wk = (const float*)d_in[8]; a.cmp_wv = (const float*)d_in[9]; a.cmp_pe = (const float*)d_in[10]; a.sinks = (const float*)d_in[11];
    a.w_in_cd = (const float*)d_in[12]; a.w_out_cd = (const float*)d_in[13]; a.ffn_w_in = (const float*)d_in[14]; a.ffn_w_out = (const float*)d_in[15];
    a.out = (float*)d_out; a.ws = (unsigned char*)d_ws;
    void* args[] = {&a};
    hipError_t e = hipLaunchCooperativeKernel((const void*)fwd_kernel, dim3(grid), dim3(512), args, LDS_BYTES, stream);
    if (e != hipSuccess) fprintf(stderr, "cooperative launch failed: %s (grid %d)\n", hipGetErrorString(e), grid);
}
```

```cpp
#include <hip/hip_runtime.h>
#include <hip/hip_cooperative_groups.h>
#include <cstdint>
#include <cstdio>
namespace cg = cooperative_groups;
#ifndef ZM
#define ZM 0
#endif
#ifndef NV
#define NV 0
#endif
#ifndef NVF
#define NVF 3
#endif
#ifndef NBR
#define NBR 7
#endif
#ifndef REP
#define REP 0
#endif
#ifndef USE_XB
#define USE_XB 1
#endif
#ifndef PH
#define PH 0xFFFF
#endif

#define LAS __attribute__((address_space(3)))
typedef _Float16 half_t;
typedef _Float16 h8 __attribute__((ext_vector_type(8)));
typedef _Float16 h4 __attribute__((ext_vector_type(4)));
typedef _Float16 h2 __attribute__((ext_vector_type(2)));
typedef float f32x16 __attribute__((ext_vector_type(16)));
typedef float f32x4 __attribute__((ext_vector_type(4)));
typedef float f32x2 __attribute__((ext_vector_type(2)));
typedef unsigned u32x4 __attribute__((ext_vector_type(4)));
typedef unsigned u32x2 __attribute__((ext_vector_type(2)));
typedef short s16x4 __attribute__((ext_vector_type(4)));
typedef LAS unsigned char* ldsp;
typedef const LAS unsigned char* cldsp;

constexpr int NB = 8, SEQ = 4096, DM = 1024, NT = NB * SEQ;
constexpr int NPROJ = 2304, DFF = 2816, NFF = 2 * DFF;
constexpr float LOG2E = 1.4426950408889634f;
constexpr float QSCALE = 0.125f * LOG2E;
constexpr float RMS_EPS = 1e-6f;
constexpr float NEG_INF = -__builtin_inff();

constexpr int AB_QA = 0, AB_KC = 512, AB_VC = 640, AB_KS = 768, AB_VS = 896, AB_KW = 1024, AB_VW = 1152, AB_QB = 1280, AB_KB = 1792, AB_VB = 1920;
constexpr int CD_QC = 0, CD_KC = 512, CD_VC = 640, CD_QD = 768, CD_KD = 1280, CD_VD = 1792;

constexpr size_t MiB = 1u << 20;
constexpr size_t WS_MODV = 1 * MiB;
constexpr size_t WS_CBIAS = 1 * MiB + 512 * 1024;
constexpr size_t WS_WKT = 2 * MiB;
constexpr size_t WS_WVT = 2 * MiB + 256 * 1024;
constexpr size_t WS_KCMP = 3 * MiB;
constexpr size_t WS_VCMP = 3 * MiB + 512 * 1024;
constexpr size_t WS_KM = 4 * MiB;
constexpr size_t WS_WGT = 4 * MiB + 64 * 1024;
constexpr size_t WS_GATE = 5 * MiB;
constexpr size_t WS_WAB = 8 * MiB;
constexpr size_t WS_WOAB = 13 * MiB;
constexpr size_t WS_WCD = 15 * MiB;
constexpr size_t WS_WOCD = 20 * MiB;
constexpr size_t WS_WFI = 22 * MiB;
constexpr size_t WS_WFO = 44 * MiB;
constexpr size_t WS_H = 64 * MiB;
constexpr size_t WS_PROJ = 128 * MiB;
constexpr size_t WS_ATT = 272 * MiB;
constexpr size_t WS_HID = 128 * MiB;
constexpr size_t WS_Y = 336 * MiB;
constexpr size_t WS_END = 464 * MiB;

constexpr int GRID = 256;
constexpr int RING_BYTES = 131072;
constexpr int LDS_BYTES = 163840;
constexpr int KP = 144;
constexpr int BT = 256;
constexpr int L_K0 = 0, L_K1 = 9216, L_V0 = 18432, L_V1 = 26624, L_BIAS = 34816, L_IMP = 43008, L_SEL = 59392, L_FLAG = 59904, L_KC = 60160, L_VC = 97024, L_ACC = 129792;
constexpr int L_XB = 163328;
static_assert(L_BIAS + 8 * BT * 4 <= L_IMP && L_VC + 32768 <= L_ACC && L_ACC + 32768 <= L_XB && L_XB + 8 <= LDS_BYTES, "lds map");

__device__ const unsigned char kBucket[128] = {
    0, 1, 2, 3, 4, 5, 6, 7, 8, 9, 10, 11, 12, 13, 14, 15, 16, 16, 16, 17, 17, 18, 18, 18, 19, 19, 19, 20, 20, 20, 20, 21, 21, 21, 21, 22, 22, 22, 22, 22, 23, 23, 23, 23, 23, 23, 24, 24, 24, 24, 24, 24,
    25, 25, 25, 25, 25, 25, 25, 26, 26, 26, 26, 26, 26, 26, 26, 27, 27, 27, 27, 27, 27, 27, 27, 27, 27, 28, 28, 28, 28, 28, 28, 28, 28, 28, 28, 29, 29, 29, 29, 29, 29, 29, 29, 29, 29, 29, 29,
    30, 30, 30, 30, 30, 30, 30, 30, 30, 30, 30, 30, 30, 30, 31, 31, 31, 31, 31, 31, 31, 31, 31, 31, 31, 31, 31, 31, 31};

namespace pg8 {
constexpr int BM = 256, BK = 64, HALF = 128, HTB = HALF * BK * 2, STAGE_BYTES = 8 * HTB, NXCD = 8, WGM = 8;
__host__ __device__ __forceinline__ int lds_byte(int r, int c) { const int st = (r >> 4) * 2 + (c >> 5), rr = r & 15, cc = c & 31, ob = rr * 64 + cc * 2; return st * 1024 + (ob ^ (((ob >> 9) & 1) << 5)); }
__host__ __device__ __forceinline__ void stage_rc(int b, int& R, int& C) { const int st = b / 1024, sb = b % 1024, swz = sb ^ (((sb >> 9) & 1) << 5); R = (st >> 1) * 16 + swz / 64; C = (st & 1) * 32 + (swz % 64) / 2; }
__host__ __device__ __forceinline__ int perm32(int rho) { const int n = rho >> 4, i = rho & 15; return 8 * (i >> 2) + 4 * n + (i & 3); }
struct Unit { int pm, pn; };
struct Gemm { const half_t* A; const half_t* Bt; int M, N, K; };
struct StaticOrder {
    int nM, nN, nwg, G, c;
    __device__ void init(int M, int N, int G_, int c_) { nM = M / BM; nN = N / BM; nwg = nM * nN; G = G_; c = c_; }
    __device__ bool next(int i, Unit& u) const {
        const long L = (long)i * G + c; if (L >= nwg) return false;
        int wgid = (int)L; { const int q = nwg / NXCD, r = nwg % NXCD, xcd = wgid % NXCD, off = wgid / NXCD; wgid = (xcd < r ? xcd * (q + 1) : r * (q + 1) + (xcd - r) * q) + off; }
        const int nig = WGM * nN, gid = wgid / nig, fm = gid * WGM, gsz = (nM - fm) < WGM ? (nM - fm) : WGM;
        u.pm = fm + ((wgid % nig) % gsz); u.pn = (wgid % nig) / gsz; return true;
    }
};

__device__ __forceinline__ unsigned pkh(float lo, float hi) { h2 v; v.x = (half_t)lo; v.y = (half_t)hi; return __builtin_bit_cast(unsigned, v); }

struct EpiProj {
    static constexpr bool PERM = true;
    half_t* O; int ldc; unsigned scale_mask;
    __device__ __forceinline__ void operator()(const f32x4 (&acc)[2][2][4][2], const Unit& u, int wr, int wc, int fr, int fq) const {
        const int row0 = u.pm * BM + wr * 64 + fr, col0 = u.pn * BM + wc * 32 + 8 * fq;
        const float sc = ((scale_mask >> u.pn) & 1u) ? QSCALE : 1.0f;
#pragma unroll
        for (int ai = 0; ai < 2; ++ai)
#pragma unroll
            for (int m = 0; m < 4; ++m) { half_t* rowp = O + (size_t)(row0 + ai * HALF + m * 16) * ldc + col0;
#pragma unroll
                for (int bj = 0; bj < 2; ++bj) { const f32x4 v0 = acc[ai][bj][m][0] * sc, v1 = acc[ai][bj][m][1] * sc;
                    u32x4 w; w.x = pkh(v0[0], v0[1]); w.y = pkh(v0[2], v0[3]); w.z = pkh(v1[0], v1[1]); w.w = pkh(v1[2], v1[3]);
                    *(u32x4*)(rowp + bj * HALF) = w; } }
    }
};
struct EpiSwiGLU {
    static constexpr bool PERM = true;
    half_t* O; int ldc;
    __device__ __forceinline__ void operator()(const f32x4 (&acc)[2][2][4][2], const Unit& u, int wr, int wc, int fr, int fq) const {
        const int row0 = u.pm * BM + wr * 64 + fr, col0 = u.pn * HALF + wc * 32 + 8 * fq;
#pragma unroll
        for (int ai = 0; ai < 2; ++ai)
#pragma unroll
            for (int m = 0; m < 4; ++m) { half_t* rowp = O + (size_t)(row0 + ai * HALF + m * 16) * ldc + col0; float r[8];
#pragma unroll
                for (int n = 0; n < 2; ++n)
#pragma unroll
                    for (int e = 0; e < 4; ++e) { const float gv = acc[ai][0][m][n][e], uv = acc[ai][1][m][n][e];
                        r[n * 4 + e] = gv * __builtin_amdgcn_rcpf(1.0f + __builtin_amdgcn_exp2f(-LOG2E * gv)) * uv; }
                u32x4 w; w.x = pkh(r[0], r[1]); w.y = pkh(r[2], r[3]); w.z = pkh(r[4], r[5]); w.w = pkh(r[6], r[7]);
                *(u32x4*)rowp = w; }
    }
};
struct EpiF32 {
    static constexpr bool PERM = false;
    float* O; int ldc;
    __device__ __forceinline__ void operator()(const f32x4 (&acc)[2][2][4][2], const Unit& u, int wr, int wc, int fr, int fq) const {
        const int row0 = u.pm * BM + wr * 64 + fr, col0 = u.pn * BM + wc * 32 + 4 * fq;
#pragma unroll
        for (int ai = 0; ai < 2; ++ai)
#pragma unroll
            for (int m = 0; m < 4; ++m) { float* rowp = O + (size_t)(row0 + ai * HALF + m * 16) * ldc + col0;
#pragma unroll
                for (int bj = 0; bj < 2; ++bj)
#pragma unroll
                    for (int n = 0; n < 2; ++n) *(f32x4*)(rowp + bj * HALF + n * 16) = acc[ai][bj][m][n]; }
    }
};

template <class Epi, class Sched, bool ALIGN_EPI>
__device__ __forceinline__ void gemm_phase(ldsp lds, const int tid, const Gemm g, const Sched& S, const Epi& E) {
    const int wid = __builtin_amdgcn_readfirstlane(tid >> 6), lane = tid & 63, wr = wid >> 2, wc = wid & 3, fr = lane & 15, fq = lane >> 4;
    const int K = g.K, nt = K / BK;
    unsigned voffA[2], voffB[2];
#pragma unroll
    for (int i = 0; i < 2; ++i) { int R, C; stage_rc(tid * 16 + i * 8192, R, C); const int Rb = Epi::PERM ? ((R & ~31) + perm32(R & 31)) : R;
        voffA[i] = (unsigned)(R * K + C) * 2u; voffB[i] = (unsigned)(Rb * K + C) * 2u; }
    const size_t kstep = (size_t)(BK * 2);
    const size_t hstep = (size_t)HALF * K * 2;
    const size_t tstep = 2 * hstep;
    const unsigned ldsw = (unsigned)wid * 1024u;
    const int aoff = lds_byte(wr * 64 + fr, fq * 8), boff = lds_byte(wc * 32 + fr, fq * 8);
#define PG8_SA(b, h) (((b) * 2 + (h)) * HTB)
#define PG8_SB(b, h) ((4 + (b) * 2 + (h)) * HTB)
#define PG8_STAGE(bufoff, gbase, voff) do { _Pragma("unroll") for (int _i = 0; _i < 2; ++_i) \
        __builtin_amdgcn_global_load_lds((const unsigned*)((const char*)(gbase) + (voff)[_i]), (LAS unsigned*)(lds + (bufoff) + ldsw + _i * 8192), 16, 0, 0); } while (0)
#define PG8_LDA(dst, b, h) do { _Pragma("unroll") for (int m = 0; m < 4; ++m) _Pragma("unroll") for (int k = 0; k < 2; ++k) dst[m][k] = *(const LAS h8*)(lds + PG8_SA(b, h) + aoff + m * 2048 + k * 1024); } while (0)
#define PG8_LDB(dst, b, h) do { _Pragma("unroll") for (int n = 0; n < 2; ++n) _Pragma("unroll") for (int k = 0; k < 2; ++k) dst[n][k] = *(const LAS h8*)(lds + PG8_SB(b, h) + boff + n * 2048 + k * 1024); } while (0)
#define PG8_MMA(ai, bj, At, Bt) do { __builtin_amdgcn_s_setprio(1); _Pragma("unroll") for (int m = 0; m < 4; ++m) _Pragma("unroll") for (int n = 0; n < 2; ++n) _Pragma("unroll") for (int k = 0; k < 2; ++k) \
        acc[ai][bj][m][n] = __builtin_amdgcn_mfma_f32_16x16x32_f16(Bt[n][k], At[m][k], acc[ai][bj][m][n], 0, 0, 0); __builtin_amdgcn_s_setprio(0); } while (0)
#define PG8_WAIT_V(n) asm volatile("s_waitcnt vmcnt(" #n ")" ::: "memory")
#define PG8_WAIT_L(n) asm volatile("s_waitcnt lgkmcnt(" #n ")" ::: "memory")
#define PG8_BAR __builtin_amdgcn_s_barrier()
#define PG8_SCHED __builtin_amdgcn_sched_barrier(0)
    Unit cur, nxt; int ui = 0;
    if (!S.next(0, cur)) return;
    f32x4 acc[2][2][4][2];
#pragma unroll
    for (int a = 0; a < 2; ++a)
#pragma unroll
        for (int b = 0; b < 2; ++b)
#pragma unroll
            for (int m = 0; m < 4; ++m)
#pragma unroll
                for (int n = 0; n < 2; ++n) acc[a][b][m][n] = (f32x4){0.f, 0.f, 0.f, 0.f};
    h8 At[4][2], B0[2][2], B1[2][2];
    const char* cA = (const char*)g.A + (size_t)cur.pm * tstep; const char* cB = (const char*)g.Bt + (size_t)cur.pn * tstep;
    PG8_STAGE(PG8_SB(0, 0), cB, voffB); PG8_STAGE(PG8_SB(0, 1), cB + hstep, voffB); PG8_STAGE(PG8_SA(0, 0), cA, voffA); PG8_STAGE(PG8_SA(0, 1), cA + hstep, voffA);
    if (wr == 1) PG8_BAR;
    PG8_WAIT_V(2); PG8_BAR;
    PG8_STAGE(PG8_SB(1, 0), cB + kstep, voffB); PG8_STAGE(PG8_SA(1, 0), cA + kstep, voffA); PG8_STAGE(PG8_SB(1, 1), cB + hstep + kstep, voffB);
    PG8_WAIT_V(6); PG8_BAR;
    for (;;) {
        const bool has_next = S.next(ui + 1, nxt);
        const char* nA = has_next ? (const char*)g.A + (size_t)nxt.pm * tstep : cA; const char* nB = has_next ? (const char*)g.Bt + (size_t)nxt.pn * tstep : cB;
        for (int t = 0; t < nt; t += 2) {
            const bool last = (t == nt - 2);
            const char* a1 = cA + (size_t)(t + 1) * kstep;
            const char* a2 = last ? nA : cA + (size_t)(t + 2) * kstep; const char* b2 = last ? nB : cB + (size_t)(t + 2) * kstep;
            const char* a3 = a2 + kstep; const char* b3 = b2 + kstep;
            PG8_LDB(B0, 0, 0); PG8_LDB(B1, 0, 1); PG8_SCHED; PG8_LDA(At, 0, 0); PG8_STAGE(PG8_SA(1, 1), a1 + hstep, voffA);
            PG8_WAIT_V(8); PG8_WAIT_L(0); PG8_BAR; PG8_MMA(0, 0, At, B0); PG8_MMA(0, 1, At, B1); PG8_BAR; PG8_SCHED;
            PG8_LDA(At, 0, 1); PG8_STAGE(PG8_SB(0, 0), b2, voffB); PG8_STAGE(PG8_SB(0, 1), b2 + hstep, voffB); PG8_STAGE(PG8_SA(0, 0), a2, voffA);
            PG8_WAIT_V(8); PG8_WAIT_L(0); PG8_BAR; PG8_MMA(1, 0, At, B0); PG8_MMA(1, 1, At, B1); PG8_BAR; PG8_SCHED;
            PG8_LDB(B0, 1, 0); PG8_LDB(B1, 1, 1); PG8_SCHED; PG8_LDA(At, 1, 0); PG8_STAGE(PG8_SA(0, 1), a2 + hstep, voffA);
            PG8_WAIT_V(8); PG8_WAIT_L(0); PG8_BAR; PG8_MMA(0, 0, At, B0); PG8_MMA(0, 1, At, B1); PG8_BAR; PG8_SCHED;
            PG8_LDA(At, 1, 1); PG8_STAGE(PG8_SB(1, 0), b3, voffB); PG8_STAGE(PG8_SB(1, 1), b3 + hstep, voffB); PG8_STAGE(PG8_SA(1, 0), a3, voffA);
            PG8_WAIT_V(8); PG8_WAIT_L(0); PG8_BAR; PG8_MMA(1, 0, At, B0); PG8_MMA(1, 1, At, B1); PG8_BAR; PG8_SCHED;
        }
        if constexpr (ALIGN_EPI) { if (wr == 0) PG8_BAR; }
        E(acc, cur, wr, wc, fr, fq);
        if (!has_next) break;
#pragma unroll
        for (int a = 0; a < 2; ++a)
#pragma unroll
            for (int b = 0; b < 2; ++b)
#pragma unroll
                for (int m = 0; m < 4; ++m)
#pragma unroll
                    for (int n = 0; n < 2; ++n) acc[a][b][m][n] = (f32x4){0.f, 0.f, 0.f, 0.f};
        cur = nxt; cA = nA; cB = nB; ++ui;
        if constexpr (ALIGN_EPI) { if (wr == 1) PG8_BAR; }
    }
    PG8_WAIT_V(0);
    if constexpr (!ALIGN_EPI) { if (wr == 0) PG8_BAR; }
    PG8_BAR;
#undef PG8_SA
#undef PG8_SB
#undef PG8_STAGE
#undef PG8_LDA
#undef PG8_LDB
#undef PG8_MMA
#undef PG8_WAIT_V
#undef PG8_WAIT_L
#undef PG8_BAR
#undef PG8_SCHED
}
}

#define XB_TMO      128
#define XB_XCNT(j)  (256  + 64 * (j))
#define XB_XSUB(j)  (1280 + 64 * (j))
#define XB_XGEN(j)  (2304 + 64 * (j))
#define XB_TOP      3328
#define XB_TOPGEN   3392
#define XCD_BAR_WORDS 3456
#define XB_SPIN_CAP (1u << 18)

__device__ __forceinline__ unsigned xb_ld(unsigned* p)              { return __hip_atomic_load(p, __ATOMIC_RELAXED, __HIP_MEMORY_SCOPE_AGENT); }
__device__ __forceinline__ unsigned xb_add(unsigned* p, unsigned v) { return __hip_atomic_fetch_add(p, v, __ATOMIC_RELAXED, __HIP_MEMORY_SCOPE_AGENT); }
__device__ __forceinline__ unsigned xb_xcc_id() { return (unsigned)__builtin_amdgcn_s_getreg((3 << 11) | 20) & 0xFu; }
#define XB_SPIN(cond, bar) do { unsigned _sp = 0; while (cond) { __builtin_amdgcn_s_sleep(1); \
    if ((++_sp & 255u) == 0u) { if (xb_ld(&(bar)[XB_TMO])) break; if (_sp > XB_SPIN_CAP) { atomicAdd(&(bar)[XB_TMO], 1u); break; } } } } while (0)

struct XcdBarrier {
    unsigned* bar; unsigned x;
    volatile LAS unsigned* st;
};

__device__ __forceinline__ XcdBarrier xcd_barrier_post(unsigned* bar, volatile LAS unsigned* st) {
    XcdBarrier b; b.bar = bar; b.x = xb_xcc_id(); b.st = st;
    if (threadIdx.x == 0) (void)xb_add(&bar[XB_XCNT(b.x)], 1u);
    return b;
}
__device__ __forceinline__ void xcd_barrier_complete(unsigned* bar, unsigned x, unsigned& nloc, unsigned& nx) {
    const unsigned G = gridDim.x * gridDim.y * gridDim.z;
    unsigned sum, cnt, mine, sp = 0u;
    for (;;) {
        sum = 0u; cnt = 0u; mine = 0u;
#pragma unroll
        for (unsigned j = 0; j < 16; ++j) { const unsigned c = xb_ld(&bar[XB_XCNT(j)]); sum += c; cnt += (c > 0u) ? 1u : 0u; mine = (j == x) ? c : mine; }
        if (sum == G) break;
        __builtin_amdgcn_s_sleep(1);
        if ((++sp & 255u) == 0u) { if (xb_ld(&bar[XB_TMO])) break; if (sp > XB_SPIN_CAP) { atomicAdd(&bar[XB_TMO], 1u); break; } }
    }
    nloc = mine > 0u ? mine : 1u; nx = cnt > 0u ? cnt : 1u;
}

__device__ __forceinline__ void xcd_barrier(const XcdBarrier& b) {
    asm volatile("s_waitcnt vmcnt(0)" ::: "memory");
    __syncthreads();
    if (threadIdx.x == 0) {
        unsigned* bar = b.bar;
        __builtin_amdgcn_s_waitcnt(0);
        unsigned nloc = b.st[0], nx = b.st[1];
        if (nloc == 0u) { xcd_barrier_complete(bar, b.x, nloc, nx); b.st[0] = nloc; b.st[1] = nx; }
        const unsigned old = xb_add(&bar[XB_XSUB(b.x)], 1u);
        const unsigned gen = old / nloc;
        if (old + 1u == (gen + 1u) * nloc) {
            __builtin_amdgcn_fence(__ATOMIC_RELEASE, "agent");
            asm volatile("s_waitcnt vmcnt(0)" ::: "memory");
            const unsigned og = xb_add(&bar[XB_TOP], 1u);
            const unsigned tg = og / nx;
            if (og + 1u == (tg + 1u) * nx) xb_add(&bar[XB_TOPGEN], 1u);
            else XB_SPIN(xb_ld(&bar[XB_TOPGEN]) == tg, bar);
            __builtin_amdgcn_fence(__ATOMIC_ACQUIRE, "agent");
            xb_add(&bar[XB_XGEN(b.x)], 1u);
            asm volatile("s_waitcnt vmcnt(0)" ::: "memory");
        } else {
            XB_SPIN(xb_ld(&bar[XB_XGEN(b.x)]) == gen, bar);
            __builtin_amdgcn_fence(__ATOMIC_ACQUIRE, "agent");
            asm volatile("s_waitcnt vmcnt(0)" ::: "memory");
        }
    }
    __syncthreads();
}


struct Args {
    const float* x; const float* c; const float* rel; const float* mod_w; const float* mod_b; const float* norm_w;
    const float* w_in_ab; const float* w_out_ab; const float* cmp_wk; const float* cmp_wv; const float* cmp_pe; const float* sinks;
    const float* w_in_cd; const float* w_out_cd; const float* ffn_w_in; const float* ffn_w_out;
    float* out; unsigned char* ws;
};

struct Ctx {
    ldsp L; int tid, lane, wave, G, vcu;
};

__device__ __forceinline__ float wave_sum(float v) {
#pragma unroll
    for (int o = 1; o < 64; o <<= 1) v += __shfl_xor(v, o);
    return v;
}

template <int MAP> __device__ __forceinline__ int src_col(int n) {
    if (MAP == 1) { return n < 1280 ? n : n + 24; }
    if (MAP == 2) { const int j = n & 255, pn = n >> 8; return j < 128 ? 128 * pn + j : DFF + 128 * pn + (j - 128); }
    if (MAP == 3) { return n < 24 ? 1280 + n : -1; }
    return n;
}
template <int MAP> __device__ __forceinline__ void transpose_item(const float* W, int K, int Nsrc, int Ndst, half_t* WT, LAS float* scr, int item, int lane) {
    const int nblk = Ndst / 32, kb = item / nblk, nb = item % nblk, k0 = 64 * kb, n0 = 32 * nb;
    const int sc = src_col<MAP>(n0 + (lane & 31));
#pragma unroll 8
    for (int i = 0; i < 32; ++i) { const int kk = 2 * i + (lane >> 5); scr[kk * 33 + (lane & 31)] = sc >= 0 ? W[(size_t)(k0 + kk) * Nsrc + sc] : 0.f; }
    asm volatile("s_waitcnt lgkmcnt(0)" ::: "memory");
    const int c = lane & 7;
#pragma unroll
    for (int j = 0; j < 4; ++j) { const int n = (lane >> 3) + 8 * j; const LAS float* s = scr + (8 * c) * 33 + n;
        u32x4 o; o.x = pg8::pkh(s[0 * 33], s[1 * 33]); o.y = pg8::pkh(s[2 * 33], s[3 * 33]); o.z = pg8::pkh(s[4 * 33], s[5 * 33]); o.w = pg8::pkh(s[6 * 33], s[7 * 33]);
        *(u32x4*)(WT + (size_t)(n0 + n) * K + k0 + 8 * c) = o; }
    asm volatile("s_waitcnt lgkmcnt(0)" ::: "memory");
}

__device__ __forceinline__ void phase_prologue(const Ctx& X, const Args& a) {
    unsigned char* ws = a.ws;
    if (blockIdx.x < 192) {
        const int ls = blockIdx.x / 48, cgp = blockIdx.x % 48, col = cgp * 64 + X.lane;
        const float* W = a.mod_w + (size_t)ls * 1024 * 3072;
        float acc[8];
#pragma unroll
        for (int b = 0; b < 8; ++b) acc[b] = 0.f;
        const int kbeg = X.wave * 128;
#pragma unroll 4
        for (int k = kbeg; k < kbeg + 128; ++k) { const float w = W[(size_t)k * 3072 + col];
#pragma unroll
            for (int b = 0; b < 8; ++b) acc[b] += a.c[b * 1024 + k] * w; }
        LAS float* red = (LAS float*)X.L;
#pragma unroll
        for (int b = 0; b < 8; ++b) red[(X.wave * 8 + b) * 64 + X.lane] = acc[b];
        __syncthreads();
        { const int b = X.wave; float s = 0.f;
#pragma unroll
          for (int w = 0; w < 8; ++w) s += red[(w * 8 + b) * 64 + X.lane];
          s += a.mod_b[ls * 3072 + col];
          ((float*)(ws + WS_MODV))[(size_t)(ls * 8 + b) * 3072 + col] = s; }
        __syncthreads();
    } else if (blockIdx.x == 192) {
        const int tsr = X.wave & 1, kq = X.wave >> 1; const float* W = tsr ? a.cmp_wv : a.cmp_wk;
        float s = 0.f;
        for (int k = kq * 512; k < kq * 512 + 512; ++k) s += a.cmp_pe[k] * W[(size_t)k * 64 + X.lane];
        LAS float* red = (LAS float*)X.L;
        red[X.wave * 64 + X.lane] = s;
        __syncthreads();
        if (X.wave < 2) { const float t = red[X.wave * 64 + X.lane] + red[(X.wave + 2) * 64 + X.lane] + red[(X.wave + 4) * 64 + X.lane] + red[(X.wave + 6) * 64 + X.lane];
            ((float*)(ws + WS_CBIAS))[X.wave * 64 + X.lane] = t; }
        __syncthreads();
    }
    LAS float* scr = (LAS float*)(X.L + 32768 + X.wave * 8704);
    const int gw = X.vcu * 8 + X.wave, NGW = X.G * 8;
    constexpr int I_AB = 16 * (2048 / 32), I_CD = 16 * (NPROJ / 32), I_O = 16 * 32, I_FI = 16 * (NFF / 32), I_FO = (DFF / 64) * 32, I_C = 32 * 2, I_G = 16;
    constexpr int NITEMS = I_AB + I_CD + 2 * I_O + 2 * I_FI + 2 * I_FO + 2 * I_C + I_G;
    for (int it = gw; it < NITEMS; it += NGW) {
        int r = it;
        if (r < I_AB) { transpose_item<1>(a.w_in_ab, 1024, 2072, 2048, (half_t*)(ws + WS_WAB), scr, r, X.lane); continue; } r -= I_AB;
        if (r < I_CD) { transpose_item<0>(a.w_in_cd, 1024, 2304, NPROJ, (half_t*)(ws + WS_WCD), scr, r, X.lane); continue; } r -= I_CD;
        if (r < I_O) { transpose_item<0>(a.w_out_ab, 1024, 1024, 1024, (half_t*)(ws + WS_WOAB), scr, r, X.lane); continue; } r -= I_O;
        if (r < I_O) { transpose_item<0>(a.w_out_cd, 1024, 1024, 1024, (half_t*)(ws + WS_WOCD), scr, r, X.lane); continue; } r -= I_O;
        if (r < 2 * I_FI) { const int l = r / I_FI; transpose_item<2>(a.ffn_w_in + (size_t)l * 1024 * NFF, 1024, NFF, NFF, (half_t*)(ws + WS_WFI) + (size_t)l * NFF * 1024, scr, r % I_FI, X.lane); continue; } r -= 2 * I_FI;
        if (r < 2 * I_FO) { const int l = r / I_FO; transpose_item<0>(a.ffn_w_out + (size_t)l * DFF * 1024, DFF, 1024, 1024, (half_t*)(ws + WS_WFO) + (size_t)l * 1024 * DFF, scr, r % I_FO, X.lane); continue; } r -= 2 * I_FO;
        if (r < I_C) { transpose_item<0>(a.cmp_wk, 2048, 64, 64, (half_t*)(ws + WS_WKT), scr, r, X.lane); continue; } r -= I_C;
        if (r < I_C) { transpose_item<0>(a.cmp_wv, 2048, 64, 64, (half_t*)(ws + WS_WVT), scr, r, X.lane); continue; } r -= I_C;
        transpose_item<3>(a.w_in_ab, 1024, 2072, 32, (half_t*)(ws + WS_WGT), scr, r, X.lane);
    }
}

__device__ __forceinline__ void rows_phase(const Ctx& X, bool has_y, bool do_h, const float* xin, const float* y, float* xo, half_t* H,
                                           const float* wpost, const float* mvpost, const float* wpre, const float* mvpre) {
    const int gw = X.vcu * 8 + X.wave, NGW = X.G * 8, lane = X.lane;
    for (int row = gw; row < NT; row += NGW) {
        const int b = row >> 12;
        f32x4 v[4];
#pragma unroll
        for (int j = 0; j < 4; ++j) v[j] = *(const f32x4*)(xin + (size_t)row * DM + 4 * lane + 256 * j);
        if (has_y) {
            f32x4 yv[4]; float ss = 0.f;
#pragma unroll
            for (int j = 0; j < 4; ++j) { yv[j] = *(const f32x4*)(y + (size_t)row * DM + 4 * lane + 256 * j); ss += (yv[j].x * yv[j].x + yv[j].y * yv[j].y) + (yv[j].z * yv[j].z + yv[j].w * yv[j].w); }
            const float rinv = 1.0f / sqrtf(wave_sum(ss) * (1.0f / DM) + RMS_EPS);
#pragma unroll
            for (int j = 0; j < 4; ++j) { const f32x4 w = *(const f32x4*)(wpost + 4 * lane + 256 * j); const f32x4 gt = *(const f32x4*)(mvpost + (size_t)b * 3072 + 2048 + 4 * lane + 256 * j);
                v[j] = v[j] + gt * (yv[j] * rinv * w); *(f32x4*)(xo + (size_t)row * DM + 4 * lane + 256 * j) = v[j]; }
        }
        if (do_h) {
            float ss = 0.f;
#pragma unroll
            for (int j = 0; j < 4; ++j) ss += (v[j].x * v[j].x + v[j].y * v[j].y) + (v[j].z * v[j].z + v[j].w * v[j].w);
            const float rinv = 1.0f / sqrtf(wave_sum(ss) * (1.0f / DM) + RMS_EPS);
#pragma unroll
            for (int j = 0; j < 4; ++j) { const f32x4 w = *(const f32x4*)(wpre + 4 * lane + 256 * j);
                const f32x4 sh = *(const f32x4*)(mvpre + (size_t)b * 3072 + 4 * lane + 256 * j), sc = *(const f32x4*)(mvpre + (size_t)b * 3072 + 1024 + 4 * lane + 256 * j);
                const f32x4 hv = (v[j] * rinv * w) * (1.0f + sc) + sh;
                u32x2 o; o.x = pg8::pkh(hv.x, hv.y); o.y = pg8::pkh(hv.z, hv.w);
                *(u32x2*)(H + (size_t)row * DM + 4 * lane + 256 * j) = o; }
        }
    }
}

__device__ __forceinline__ float xh_max(float v) { auto rr = __builtin_amdgcn_permlane32_swap(__float_as_uint(v), __float_as_uint(v), false, false); return fmaxf(__uint_as_float(rr[0]), __uint_as_float(rr[1])); }
__device__ __forceinline__ float xh_sum(float v) { auto rr = __builtin_amdgcn_permlane32_swap(__float_as_uint(v), __float_as_uint(v), false, false); return __uint_as_float(rr[0]) + __uint_as_float(rr[1]); }
__device__ __forceinline__ float xh_get(float v, int h) { auto rr = __builtin_amdgcn_permlane32_swap(__float_as_uint(v), __float_as_uint(v), false, false); return h ? __uint_as_float(rr[0]) : __uint_as_float(rr[1]); }
__device__ __forceinline__ float quad_sum(float v) {
    v += __int_as_float(__builtin_amdgcn_update_dpp(0, __float_as_int(v), 0xB1, 0xf, 0xf, false));
    v += __int_as_float(__builtin_amdgcn_update_dpp(0, __float_as_int(v), 0x4E, 0xf, 0xf, false));
    return v;
}
__device__ __forceinline__ unsigned pk_rtz(float a, float b) { return __builtin_bit_cast(unsigned, __builtin_amdgcn_cvt_pkrtz(a, b)); }
__device__ __forceinline__ int krow(int r, int h) { return (r & 3) + 8 * (r >> 2) + 4 * h; }

__device__ __forceinline__ void qk64(f32x16& s0, f32x16& s1, cldsp kb, const h8 (&qf)[4], float init, int r, int h) {
#pragma unroll
    for (int i = 0; i < 16; ++i) { s0[i] = init; s1[i] = init; }
    cldsp p = kb + r * KP + h * 16;
#pragma unroll
    for (int kd = 0; kd < 4; ++kd) {
        const h8 a0 = *(const LAS h8*)(p + kd * 32), a1 = *(const LAS h8*)(p + 32 * KP + kd * 32);
        s0 = __builtin_amdgcn_mfma_f32_32x32x16_f16(a0, qf[kd], s0, 0, 0, 0);
        s1 = __builtin_amdgcn_mfma_f32_32x32x16_f16(a1, qf[kd], s1, 0, 0, 0);
    }
}
__device__ __forceinline__ void qk32(f32x16& s0, cldsp kb, const h8 (&qf)[4], int r, int h) {
#pragma unroll
    for (int i = 0; i < 16; ++i) s0[i] = 0.f;
    cldsp p = kb + r * KP + h * 16;
#pragma unroll
    for (int kd = 0; kd < 4; ++kd) { const h8 a0 = *(const LAS h8*)(p + kd * 32); s0 = __builtin_amdgcn_mfma_f32_32x32x16_f16(a0, qf[kd], s0, 0, 0, 0); }
}
__device__ __forceinline__ void pv64(f32x16& o0, f32x16& o1, cldsp vb, int dstride, const f32x16& p0, const f32x16& p1, int lane) {
    const int h = lane >> 5, q = (lane & 15) >> 2, p = lane & 3, gb = (lane >> 4) & 1;
    cldsp base = vb + (4 * h + q) * 64 + (16 * gb + 4 * p) * 2;
#pragma unroll
    for (int ks = 0; ks < 4; ++ks) {
        const f32x16& P = (ks < 2) ? p0 : p1; const int rb = 8 * (ks & 1);
        u32x4 w; w.x = pk_rtz(P[rb + 0], P[rb + 1]); w.y = pk_rtz(P[rb + 2], P[rb + 3]); w.z = pk_rtz(P[rb + 4], P[rb + 5]); w.w = pk_rtz(P[rb + 6], P[rb + 7]);
        const h8 pb = __builtin_bit_cast(h8, w);
#pragma unroll
        for (int dh = 0; dh < 2; ++dh) {
            const s16x4 lo = __builtin_amdgcn_ds_read_tr16_b64_v4i16((LAS s16x4*)(base + dh * dstride + (16 * ks) * 64));
            const s16x4 hi = __builtin_amdgcn_ds_read_tr16_b64_v4i16((LAS s16x4*)(base + dh * dstride + (16 * ks + 8) * 64));
            typedef short s16x8 __attribute__((ext_vector_type(8)));
            const s16x8 av = __builtin_shufflevector(lo, hi, 0, 1, 2, 3, 4, 5, 6, 7);
            const h8 a = __builtin_bit_cast(h8, av);
            if (dh == 0) o0 = __builtin_amdgcn_mfma_f32_32x32x16_f16(a, pb, o0, 0, 0, 0);
            else o1 = __builtin_amdgcn_mfma_f32_32x32x16_f16(a, pb, o1, 0, 0, 0);
        }
    }
}
template <bool WITH_O> __device__ __forceinline__ void softmax_step(f32x16& s0, f32x16& s1, float& m, float& l, f32x16& o0, f32x16& o1) {
    float mx = fmaxf(s0[0], s1[0]);
#pragma unroll
    for (int i = 1; i < 16; ++i) mx = fmaxf(mx, fmaxf(s0[i], s1[i]));
    mx = xh_max(mx);
    const float mn = fmaxf(m, mx), mu = (mn == NEG_INF) ? 0.f : mn;
    const float alpha = __builtin_amdgcn_exp2f(m - mu);
    float sum = 0.f;
#pragma unroll
    for (int i = 0; i < 16; ++i) { s0[i] = __builtin_amdgcn_exp2f(s0[i] - mu); s1[i] = __builtin_amdgcn_exp2f(s1[i] - mu); sum += s0[i] + s1[i]; }
    l = l * alpha + sum; m = mn;
    if (WITH_O) { if (__any(alpha != 1.0f)) { o0 *= alpha; o1 *= alpha; } }
}
__device__ __forceinline__ void tile_load(u32x4& kr, u32x4& vr, const half_t* Kg, const half_t* Vg, size_t pitch, int tid) {
    const int key = tid >> 3, ch = tid & 7;
    kr = *(const u32x4*)(Kg + (size_t)key * pitch + ch * 8); vr = *(const u32x4*)(Vg + (size_t)key * pitch + ch * 8);
}
__device__ __forceinline__ void tile_store(ldsp kb, ldsp vb, const u32x4& kr, const u32x4& vr, int tid) {
    const int key = tid >> 3, ch = tid & 7;
    *(LAS u32x4*)(kb + key * KP + ch * 16) = kr; *(LAS u32x4*)(vb + (ch >> 2) * 4096 + key * 64 + (ch & 3) * 16) = vr;
}
__device__ __forceinline__ void build_bias(const Ctx& X, const float* rel, int sb) {
    LAS float* bt = (LAS float*)(X.L + L_BIAS);
    for (int i = X.tid; i < 8 * BT; i += 512) { const int hs = i / BT, d = i % BT - 64; bt[i] = d < 0 ? 0.f : rel[(int)kBucket[min(d, 127)] * 16 + sb + hs] * LOG2E; }
    __syncthreads();
}
template <int WIN> __device__ __forceinline__ void mask_near(f32x16& s0, f32x16& s1, const LAS float* btl, int Dl, bool mine) {
#pragma unroll
    for (int i = 0; i < 16; ++i) { const int c0 = (i & 3) + 8 * (i >> 2), c1 = c0 + 32;
        const float b0 = btl[59 - c0], b1 = btl[59 - c1];
        const bool v0 = mine && Dl >= c0 && (WIN >= 8192 || Dl < WIN + c0), v1 = mine && Dl >= c1 && (WIN >= 8192 || Dl < WIN + c1);
        s0[i] = v0 ? s0[i] + b0 : NEG_INF; s1[i] = v1 ? s1[i] + b1 : NEG_INF; }
}
__device__ __forceinline__ void store_col(half_t* dst, const f32x16& o0, const f32x16& o1, float sc, int h) {
#pragma unroll
    for (int dh = 0; dh < 2; ++dh)
#pragma unroll
        for (int gi = 0; gi < 4; ++gi) { const f32x16& o = dh ? o1 : o0;
            u32x2 w; w.x = pg8::pkh(o[4 * gi] * sc, o[4 * gi + 1] * sc); w.y = pg8::pkh(o[4 * gi + 2] * sc, o[4 * gi + 3] * sc);
            *(u32x2*)(dst + 32 * dh + 8 * gi + 4 * h) = w; }
}

__device__ __forceinline__ void acc_set(LAS unsigned* accL, const f32x16& o0, const f32x16& o1, float sc) {
#pragma unroll
    for (int i = 0; i < 8; ++i) { accL[i * 512] = pg8::pkh(o0[2 * i] * sc, o0[2 * i + 1] * sc); accL[(8 + i) * 512] = pg8::pkh(o1[2 * i] * sc, o1[2 * i + 1] * sc); }
}
__device__ __forceinline__ void acc_add(LAS unsigned* accL, const f32x16& o0, const f32x16& o1, float sc) {
#pragma unroll
    for (int i = 0; i < 8; ++i) { const h2 p0 = __builtin_bit_cast(h2, accL[i * 512]), p1 = __builtin_bit_cast(h2, accL[(8 + i) * 512]);
        accL[i * 512] = pg8::pkh((float)p0.x + o0[2 * i] * sc, (float)p0.y + o0[2 * i + 1] * sc); accL[(8 + i) * 512] = pg8::pkh((float)p1.x + o1[2 * i] * sc, (float)p1.y + o1[2 * i + 1] * sc); }
}
__device__ __forceinline__ void acc_store(half_t* dst, const LAS unsigned* accL, const f32x16& o0, const f32x16& o1, float sc, bool add_old) {
#pragma unroll
    for (int dh = 0; dh < 2; ++dh)
#pragma unroll
        for (int gi = 0; gi < 4; ++gi) { const f32x16& o = dh ? o1 : o0;
            const h2 p0 = __builtin_bit_cast(h2, accL[(8 * dh + 2 * gi) * 512]), p1 = __builtin_bit_cast(h2, accL[(8 * dh + 2 * gi + 1) * 512]);
            float v0 = (float)p0.x + o[4 * gi] * sc, v1 = (float)p0.y + o[4 * gi + 1] * sc, v2 = (float)p1.x + o[4 * gi + 2] * sc, v3 = (float)p1.y + o[4 * gi + 3] * sc;
            if (add_old) { const u32x2 old = *(const u32x2*)(dst + 32 * dh + 8 * gi); const h2 a0 = __builtin_bit_cast(h2, old.x), a1 = __builtin_bit_cast(h2, old.y);
                v0 += (float)a0.x; v1 += (float)a0.y; v2 += (float)a1.x; v3 += (float)a1.y; }
            u32x2 w; w.x = pg8::pkh(v0, v1); w.y = pg8::pkh(v2, v3);
            *(u32x2*)(dst + 32 * dh + 8 * gi) = w; }
}

template <int WIN> __device__ __forceinline__ void banded_attn(const Ctx& X, const half_t* Kg, const half_t* Vg, int t0, const h8 (&qf)[4], int tq, int hs,
                                                               float m_init, float l_init, f32x16& o0, f32x16& o1, float& l_out) {
    const int lane = X.lane, r = lane & 31, h = lane >> 5;
    const LAS float* bt = (const LAS float*)(X.L + L_BIAS) + hs * BT;
    const float bfar = bt[64 + 127];
    float m = m_init, l = l_init;
#pragma unroll
    for (int i = 0; i < 16; ++i) { o0[i] = 0.f; o1[i] = 0.f; }
    int kfirst = t0 - WIN; if (kfirst < 0) kfirst = 0;
    const int ntile = (t0 - kfirst) / 64 + 1;
    u32x4 kr, vr;
    tile_load(kr, vr, Kg + (size_t)kfirst * NPROJ, Vg + (size_t)kfirst * NPROJ, NPROJ, X.tid);
#pragma unroll 1
    for (int i = 0; i < ntile; ++i) {
        const int k0 = kfirst + 64 * i; const int buf = i & 1;
        ldsp kb = X.L + (buf ? L_K1 : L_K0), vb = X.L + (buf ? L_V1 : L_V0);
        tile_store(kb, vb, kr, vr, X.tid);
        __syncthreads();
        if (i + 1 < ntile) tile_load(kr, vr, Kg + (size_t)(k0 + 64) * NPROJ, Vg + (size_t)(k0 + 64) * NPROJ, NPROJ, X.tid);
        f32x16 s0, s1;
        const int Dl = tq - k0 - 4 * h;
        if (k0 >= t0 - 128) { qk64(s0, s1, kb, qf, 0.f, r, h); mask_near<WIN>(s0, s1, bt + (Dl + 5), Dl, true); }
        else { qk64(s0, s1, kb, qf, bfar, r, h);
            if (WIN > 128 && k0 == t0 - WIN) {
#pragma unroll
                for (int i2 = 0; i2 < 16; ++i2) { const int c0 = (i2 & 3) + 8 * (i2 >> 2), c1 = c0 + 32; s0[i2] = (Dl < WIN + c0) ? s0[i2] : NEG_INF; s1[i2] = (Dl < WIN + c1) ? s1[i2] : NEG_INF; } } }
        softmax_step<true>(s0, s1, m, l, o0, o1);
        pv64(o0, o1, vb, 4096, s0, s1, lane);
    }
    __syncthreads();
    l_out = xh_sum(l);
}

__device__ __forceinline__ void gate_job(const Ctx& X, const Args& a, int tile32) {
    const int lane = X.lane, r = lane & 31, h = lane >> 5;
    const half_t* Hrow = (const half_t*)(a.ws + WS_H) + (size_t)(32 * tile32 + r) * DM + 8 * h;
    const half_t* Wrow = (const half_t*)(a.ws + WS_WGT) + (size_t)r * DM + 8 * h;
    f32x16 c;
#pragma unroll
    for (int i = 0; i < 16; ++i) c[i] = 0.f;
#pragma unroll 8
    for (int ks = 0; ks < 64; ++ks) { const h8 av = *(const h8*)(Wrow + 16 * ks), bv = *(const h8*)(Hrow + 16 * ks); c = __builtin_amdgcn_mfma_f32_32x32x16_f16(av, bv, c, 0, 0, 0); }
    half_t* dst = (half_t*)(a.ws + WS_GATE) + (size_t)(32 * tile32 + r) * 32;
#pragma unroll
    for (int gi = 0; gi < 4; ++gi) { float s[4];
#pragma unroll
        for (int k = 0; k < 4; ++k) s[k] = __builtin_amdgcn_rcpf(1.0f + __builtin_amdgcn_exp2f(-LOG2E * c[4 * gi + k]));
        u32x2 w; w.x = pg8::pkh(s[0], s[1]); w.y = pg8::pkh(s[2], s[3]);
        *(u32x2*)(dst + 8 * gi + 4 * h) = w; }
}

__device__ __forceinline__ void swa_unit(const Ctx& X, const Args& a, int b, int g, int tile) {
    const int lane = X.lane, r = lane & 31, h = lane >> 5, hd = r & 3, head = 4 * g + hd, tq = 64 * tile + 8 * X.wave + (r >> 2);
    const half_t* P = (const half_t*)(a.ws + WS_PROJ) + (size_t)b * SEQ * NPROJ;
    const half_t* prow = P + (size_t)tq * NPROJ;
    h8 qf[4];
#pragma unroll
    for (int kd = 0; kd < 4; ++kd) qf[kd] = *(const h8*)(prow + AB_QB + head * 64 + 16 * kd + 8 * h);
    const float sink2 = a.sinks[head] * LOG2E;
    f32x16 o0, o1; float l;
    banded_attn<128>(X, P + AB_KB + g * 64, P + AB_VB + g * 64, 64 * tile, qf, tq, head, sink2, h == 0 ? 1.0f : 0.0f, o0, o1, l);
    half_t* dst = (half_t*)(a.ws + WS_ATT) + ((size_t)b * SEQ + tq) * DM + 512 + head * 64;
    store_col(dst, o0, o1, (ZM & 2) ? 0.f : 1.0f / l, h);
}

__device__ __forceinline__ void compress_job(const Ctx& X, const Args& a, int job) {
    const int ntile = job & 7, tsr = (job >> 3) & 1, g = (job >> 4) & 1, b = job >> 5;
    const int lane = X.lane, r = lane & 31, h = lane >> 5;
    const half_t* P = (const half_t*)(a.ws + WS_PROJ) + (size_t)b * SEQ * NPROJ + (tsr ? AB_VC : AB_KC) + g * 64;
    const half_t* WT = (const half_t*)(a.ws + (tsr ? WS_WVT : WS_WKT));
    const int n = 32 * ntile + r;
    f32x16 c0, c1;
#pragma unroll
    for (int i = 0; i < 16; ++i) { c0[i] = 0.f; c1[i] = 0.f; }
#pragma unroll 4
    for (int ks = X.wave * 16; ks < X.wave * 16 + 16; ++ks) {
        const int kk0 = 16 * ks, l = kk0 >> 6, d0 = kk0 & 63;
        const int tok = min(16 * n + l, SEQ - 1);
        const h8 av = *(const h8*)(P + (size_t)tok * NPROJ + d0 + 8 * h);
        const h8 b0 = *(const h8*)(WT + (size_t)r * 2048 + kk0 + 8 * h), b1 = *(const h8*)(WT + (size_t)(32 + r) * 2048 + kk0 + 8 * h);
        c0 = __builtin_amdgcn_mfma_f32_32x32x16_f16(av, b0, c0, 0, 0, 0);
        c1 = __builtin_amdgcn_mfma_f32_32x32x16_f16(av, b1, c1, 0, 0, 0);
    }
    LAS float* red = (LAS float*)X.L + X.wave * 2048;
#pragma unroll
    for (int i = 0; i < 16; ++i) { red[krow(i, h) * 64 + r] = c0[i]; red[krow(i, h) * 64 + 32 + r] = c1[i]; }
    __syncthreads();
    const float* cb = (const float*)(a.ws + WS_CBIAS) + tsr * 64;
    half_t* dst = (half_t*)(a.ws + (tsr ? WS_VCMP : WS_KCMP)) + ((size_t)(b * 2 + g) * 256 + 32 * ntile) * 64;
    for (int i = X.tid; i < 2048; i += 512) { float s = 0.f;
#pragma unroll
        for (int w = 0; w < 8; ++w) s += ((const LAS float*)X.L)[w * 2048 + i];
        dst[i] = (half_t)(s + cb[i & 63]); }
    __syncthreads();
}

__device__ __forceinline__ void nsa_unit(const Ctx& X, const Args& a, int b, int g, int tile) {
    const int lane = X.lane, r = lane & 31, h = lane >> 5, hd = r & 3, head = 4 * g + hd, tokl = 8 * X.wave + (r >> 2), t0 = 64 * tile, tq = t0 + tokl, own = tile;
    const half_t* P = (const half_t*)(a.ws + WS_PROJ) + (size_t)b * SEQ * NPROJ;
    const half_t* prow = P + (size_t)tq * NPROJ;
    h8 qf[4];
#pragma unroll
    for (int kd = 0; kd < 4; ++kd) qf[kd] = *(const h8*)(prow + AB_QA + head * 64 + 16 * kd + 8 * h);
    const half_t* grow = (const half_t*)(a.ws + WS_GATE) + ((size_t)b * SEQ + tq) * 32 + head * 3;
    const float g_c = (float)grow[0], g_s = (float)grow[1], g_w = (float)grow[2];
    const LAS float* bt = (const LAS float*)(X.L + L_BIAS) + head * BT;
    half_t* const dst = (half_t*)(a.ws + WS_ATT) + ((size_t)b * SEQ + tq) * DM + head * 64 + 4 * h;
    LAS unsigned* const accp = (LAS unsigned*)(X.L + L_ACC) + X.tid;
    {
        const int ncv = min(255, t0 / 16 + 3), nct = (ncv + 63) >> 6;
        const half_t* KCg = (const half_t*)(a.ws + WS_KCMP) + (size_t)(b * 2 + g) * 256 * 64;
        const half_t* VCg = (const half_t*)(a.ws + WS_VCMP) + (size_t)(b * 2 + g) * 256 * 64;
        for (int i = X.tid; i < nct * 512; i += 512) { const int key = i >> 3, ch = i & 7;
            const u32x4 kv = *(const u32x4*)(KCg + key * 64 + ch * 8), vv = *(const u32x4*)(VCg + key * 64 + ch * 8);
            *(LAS u32x4*)(X.L + L_KC + key * KP + ch * 16) = kv; *(LAS u32x4*)(X.L + L_VC + (ch >> 2) * 16384 + key * 64 + (ch & 3) * 16) = vv; }
        __syncthreads();
        float m = NEG_INF, l = 0.f; f32x16 o0, o1;
#pragma unroll
        for (int i = 0; i < 16; ++i) { o0[i] = 0.f; o1[i] = 0.f; }
#pragma unroll 1
        for (int ct = 0; ct < nct; ++ct) {
            f32x16 s0, s1; qk64(s0, s1, X.L + L_KC + ct * 64 * KP, qf, 0.f, r, h);
#pragma unroll
            for (int i = 0; i < 16; ++i) { const int d0 = tq - (16 * (64 * ct + krow(i, h)) + 31), d1 = d0 - 512;
                s0[i] = d0 >= 0 ? s0[i] + bt[64 + min(d0, 127)] : NEG_INF; s1[i] = d1 >= 0 ? s1[i] + bt[64 + min(d1, 127)] : NEG_INF; }
            softmax_step<false>(s0, s1, m, l, o0, o1);
        }
        l = xh_sum(l);
        const float inv = l > 0.f ? 1.0f / l : 0.f, mu = (m == NEG_INF) ? 0.f : m;
        LAS float* impL = (LAS float*)(X.L + L_IMP) + tokl * 64;
        float carry = 0.f;
#pragma unroll 1
        for (int ct = 0; ct < nct; ++ct) {
            f32x16 s0, s1; qk64(s0, s1, X.L + L_KC + ct * 64 * KP, qf, 0.f, r, h);
#pragma unroll
            for (int i = 0; i < 16; ++i) { const int d0 = tq - (16 * (64 * ct + krow(i, h)) + 31), d1 = d0 - 512;
                s0[i] = d0 >= 0 ? __builtin_amdgcn_exp2f(s0[i] + bt[64 + min(d0, 127)] - mu) * inv : 0.f;
                s1[i] = d1 >= 0 ? __builtin_amdgcn_exp2f(s1[i] + bt[64 + min(d1, 127)] - mu) * inv : 0.f; }
#pragma unroll
            for (int hf = 0; hf < 2; ++hf) {
                const f32x16& pp = hf ? s1 : s0; const int ht = 2 * ct + hf;
                float A[4], Eo[4], Xp[4];
#pragma unroll
                for (int gi = 0; gi < 4; ++gi) { Eo[gi] = 0.5f * pp[4 * gi + 3]; A[gi] = (pp[4 * gi] + pp[4 * gi + 1]) + (pp[4 * gi + 2] + Eo[gi]); }
#pragma unroll
                for (int gi = 0; gi < 4; ++gi) Xp[gi] = xh_get(Eo[gi], h);
#pragma unroll
                for (int gi = 0; gi < 4; ++gi) { const float recv = h ? Xp[gi] : (gi == 0 ? carry : Xp[gi > 0 ? gi - 1 : 0]);
                    const float v = quad_sum(A[gi] + recv);
                    if (hd == 0) impL[8 * ht + 2 * gi + h] = v; }
                carry = Xp[3];
            }
            pv64(o0, o1, X.L + L_VC + ct * 64 * 64, 16384, s0, s1, lane);
        }
        acc_set(accp, o0, o1, ((ZM & 1) || !(NBR & 1)) ? 0.f : g_c);
    }
    unsigned long long umask = 0ull, mymask;
    {
        LAS unsigned long long* selL = (LAS unsigned long long*)(X.L + L_SEL);
        const bool causal = lane <= own, forced = (lane == 0) || (lane == own) || (lane == own - 1);
#pragma unroll 1
        for (int tk = 0; tk < 8; ++tk) {
            const float v = ((const LAS float*)(X.L + L_IMP))[(8 * X.wave + tk) * 64 + lane];
            const float key = causal ? (v + (forced ? 1e4f : 0.f)) : -1e30f;
            int cnt = 0;
#pragma unroll 8
            for (int j = 0; j < 64; ++j) { const float kj = __int_as_float(__builtin_amdgcn_readlane(__float_as_int(key), j)); cnt += ((kj > key) || (kj == key && j < lane)) ? 1 : 0; }
            const unsigned long long mk = __ballot((cnt < 8) && causal);
            if (lane == 0) selL[8 * X.wave + tk] = mk;
            umask |= mk;
        }
        mymask = selL[tokl];
    }
    {
        const half_t* Kg = P + AB_KS + g * 64; const half_t* Vg = P + AB_VS + g * 64;
        float m = NEG_INF, l = 0.f; f32x16 o0, o1;
#pragma unroll
        for (int i = 0; i < 16; ++i) { o0[i] = 0.f; o1[i] = 0.f; }
        u32x4 kr, vr; tile_load(kr, vr, Kg, Vg, NPROJ, X.tid);
#pragma unroll 1
        for (int s = 0; s <= own; ++s) {
            const int buf = s & 1; ldsp kb = X.L + (buf ? L_K1 : L_K0), vb = X.L + (buf ? L_V1 : L_V0);
            tile_store(kb, vb, kr, vr, X.tid);
            __syncthreads();
            if (s + 1 <= own) tile_load(kr, vr, Kg + (size_t)(64 * s + 64) * NPROJ, Vg + (size_t)(64 * s + 64) * NPROJ, NPROJ, X.tid);
            if ((umask >> s) & 1ull) {
                f32x16 s0, s1;
                const bool mine = (mymask >> s) & 1ull; const int Dl = tq - 64 * s - 4 * h;
                if (s >= own - 2) { qk64(s0, s1, kb, qf, 0.f, r, h); mask_near<8192>(s0, s1, bt + (Dl + 5), Dl, mine); }
                else qk64(s0, s1, kb, qf, mine ? bt[64 + 127] : NEG_INF, r, h);
                softmax_step<true>(s0, s1, m, l, o0, o1);
                pv64(o0, o1, vb, 4096, s0, s1, lane);
            }
        }
        __syncthreads();
        l = xh_sum(l); const float sc = ((ZM & 1) || !(NBR & 2)) ? 0.f : g_s / l;
        acc_add(accp, o0, o1, sc);
    }
    {
        f32x16 o0, o1; float l;
        banded_attn<512>(X, P + AB_KW + g * 64, P + AB_VW + g * 64, t0, qf, tq, head, NEG_INF, 0.f, o0, o1, l);
        const float sc = ((ZM & 1) || !(NBR & 4)) ? 0.f : g_w / l;
        acc_store(dst, accp, o0, o1, sc, NBR != 7);
    }
}

__device__ __forceinline__ void kmean_job(const Ctx& X, const Args& a, int job) {
    const int j = job & 15, g = (job >> 4) & 1, b = job >> 5, key = X.tid >> 3, ch = X.tid & 7;
    const half_t* Kg = (const half_t*)(a.ws + WS_PROJ) + ((size_t)b * SEQ + 256 * j) * NPROJ + CD_KC + g * 64;
    float s[8];
#pragma unroll
    for (int e = 0; e < 8; ++e) s[e] = 0.f;
#pragma unroll
    for (int it = 0; it < 4; ++it) { const h8 v = *(const h8*)(Kg + (size_t)(key + 64 * it) * NPROJ + ch * 8);
#pragma unroll
        for (int e = 0; e < 8; ++e) s[e] += (float)v[e]; }
    LAS float* red = (LAS float*)X.L;
#pragma unroll
    for (int e = 0; e < 8; ++e) red[key * 64 + ch * 8 + e] = s[e];
    __syncthreads();
    if (X.tid < 64) { float t = 0.f;
        for (int k = 0; k < 64; ++k) t += red[k * 64 + X.tid];
        t *= (1.0f / 16.0f);
        const half_t hi = (half_t)t, lo = (half_t)(t - (float)hi);
        half_t* dst = (half_t*)(a.ws + WS_KM) + (size_t)(b * 2 + g) * 32 * 64;
        dst[j * 64 + X.tid] = hi; dst[(16 + j) * 64 + X.tid] = lo; }
    __syncthreads();
}

__device__ __forceinline__ void moba_unit(const Ctx& X, const Args& a, int b, int g, int tile) {
    const int lane = X.lane, r = lane & 31, h = lane >> 5, hd = r & 3, head = 4 * g + hd, t0 = 64 * tile, tq = t0 + 8 * X.wave + (r >> 2), ownb = tile >> 2;
    const half_t* P = (const half_t*)(a.ws + WS_PROJ) + (size_t)b * SEQ * NPROJ;
    const half_t* prow = P + (size_t)tq * NPROJ;
    h8 qf[4];
#pragma unroll
    for (int kd = 0; kd < 4; ++kd) qf[kd] = *(const h8*)(prow + CD_QC + head * 64 + 16 * kd + 8 * h);
    const LAS float* bt = (const LAS float*)(X.L + L_BIAS) + head * BT;
    unsigned sel16 = 0u;
    {
        const half_t* KMg = (const half_t*)(a.ws + WS_KM) + (size_t)(b * 2 + g) * 32 * 64;
        if (X.tid < 256) { const int key = X.tid >> 3, ch = X.tid & 7; *(LAS u32x4*)(X.L + L_K0 + key * KP + ch * 16) = *(const u32x4*)(KMg + key * 64 + ch * 8); }
        __syncthreads();
        f32x16 sg; qk32(sg, X.L + L_K0, qf, r, h);
        float gsv[16];
#pragma unroll
        for (int i = 0; i < 8; ++i) { const float mine = sg[i] + sg[i + 8], other = xh_get(mine, h); const int jl = (i & 3) + 8 * (i >> 2);
            gsv[jl] = h ? other : mine; gsv[jl + 4] = h ? mine : other; }
#pragma unroll
        for (int rep = 0; rep < 3; ++rep) { float best = NEG_INF; int bi = -1;
#pragma unroll
            for (int j = 0; j < 16; ++j) { const bool ok = (j < ownb) && !((sel16 >> j) & 1u); if (ok && gsv[j] > best) { best = gsv[j]; bi = j; } }
            if (bi >= 0) sel16 |= 1u << bi; }
        __syncthreads();
    }
    unsigned umask = 0u;
#pragma unroll
    for (int j = 0; j < 16; ++j) if (__ballot((sel16 >> j) & 1u) != 0ull) umask |= 1u << j;
    const half_t* Kg = P + CD_KC + g * 64; const half_t* Vg = P + CD_VC + g * 64;
    float m = NEG_INF, l = 0.f; f32x16 o0, o1;
#pragma unroll
    for (int i = 0; i < 16; ++i) { o0[i] = 0.f; o1[i] = 0.f; }
    u32x4 kr, vr; tile_load(kr, vr, Kg, Vg, NPROJ, X.tid);
    for (int kt = 0; kt <= tile; ++kt) {
        const int buf = kt & 1; ldsp kb = X.L + (buf ? L_K1 : L_K0), vb = X.L + (buf ? L_V1 : L_V0);
        tile_store(kb, vb, kr, vr, X.tid);
        __syncthreads();
        if (kt + 1 <= tile) tile_load(kr, vr, Kg + (size_t)(64 * kt + 64) * NPROJ, Vg + (size_t)(64 * kt + 64) * NPROJ, NPROJ, X.tid);
        const int blk = kt >> 2; const bool past = blk < ownb;
        if (!past || ((umask >> blk) & 1u)) {
            f32x16 s0, s1;
            const bool mine = past ? ((sel16 >> blk) & 1u) : true; const int Dl = tq - 64 * kt - 4 * h;
            if (kt >= tile - 2) { qk64(s0, s1, kb, qf, 0.f, r, h); mask_near<8192>(s0, s1, bt + (Dl + 5), Dl, mine); }
            else qk64(s0, s1, kb, qf, mine ? bt[64 + 127] : NEG_INF, r, h);
            softmax_step<true>(s0, s1, m, l, o0, o1);
            pv64(o0, o1, vb, 4096, s0, s1, lane);
        }
    }
    __syncthreads();
    l = xh_sum(l);
    half_t* dst = (half_t*)(a.ws + WS_ATT) + ((size_t)b * SEQ + tq) * DM + head * 64;
    store_col(dst, o0, o1, (ZM & 4) ? 0.f : 1.0f / l, h);
}

__device__ __forceinline__ void stick_unit(const Ctx& X, const Args& a, int b, int head, int tile) {
    const int lane = X.lane, r = lane & 31, h = lane >> 5, t0 = 256 * tile, tq = t0 + 32 * X.wave + r;
    const half_t* P = (const half_t*)(a.ws + WS_PROJ) + (size_t)b * SEQ * NPROJ;
    const half_t* prow = P + (size_t)tq * NPROJ;
    h8 qf[4];
#pragma unroll
    for (int kd = 0; kd < 4; ++kd) qf[kd] = *(const h8*)(prow + CD_QD + head * 64 + 16 * kd + 8 * h);
    const half_t* Kg = P + CD_KD + head * 64; const half_t* Vg = P + CD_VD + head * 64;
    LAS int* flags = (LAS int*)(X.L + L_FLAG);
    if (X.tid < 16) flags[X.tid] = 0;
    f32x16 o0, o1;
#pragma unroll
    for (int i = 0; i < 16; ++i) { o0[i] = 0.f; o1[i] = 0.f; }
    float carry = 1.0f; bool done = false;
    const int kt_top = 4 * tile + 3, ktw = 4 * tile + (X.wave >> 1);
    u32x4 kr, vr; tile_load(kr, vr, Kg + (size_t)(64 * kt_top) * NPROJ, Vg + (size_t)(64 * kt_top) * NPROJ, NPROJ, X.tid);
    for (int i = 0; i <= kt_top; ++i) {
        const int kt = kt_top - i, k0 = 64 * kt, buf = i & 1; ldsp kb = X.L + (buf ? L_K1 : L_K0), vb = X.L + (buf ? L_V1 : L_V0);
        tile_store(kb, vb, kr, vr, X.tid);
        __syncthreads();
        { int alld = 1;
#pragma unroll
          for (int w = 0; w < 8; ++w) alld &= flags[((i + 1) & 1) * 8 + w];
          if (alld) break; }
        if (kt > 0) tile_load(kr, vr, Kg + (size_t)(k0 - 64) * NPROJ, Vg + (size_t)(k0 - 64) * NPROJ, NPROJ, X.tid);
        if (kt <= ktw && !done) {
            f32x16 s0, s1; qk64(s0, s1, kb, qf, 0.f, r, h);
#pragma unroll
            for (int hf = 1; hf >= 0; --hf) {
                f32x16& z = hf ? s1 : s0;
                float T[4], To[4];
#pragma unroll
                for (int gi = 0; gi < 4; ++gi) {
                    float u[4], sg[4];
#pragma unroll
                    for (int k = 0; k < 4; ++k) { const int kpos = k0 + 32 * hf + 8 * gi + 4 * h + k; const bool valid = kpos < tq;
                        const float e = __builtin_amdgcn_exp2f(z[4 * gi + k]); const float uu = __builtin_amdgcn_rcpf(1.0f + e);
                        u[k] = valid ? uu : 1.0f; sg[k] = valid ? 1.0f - uu : 0.f; }
                    const float e2 = u[3], e1 = e2 * u[2], e0 = e1 * u[1];
                    T[gi] = e0 * u[0];
                    z[4 * gi + 3] = sg[3]; z[4 * gi + 2] = sg[2] * e2; z[4 * gi + 1] = sg[1] * e1; z[4 * gi] = sg[0] * e0;
                }
#pragma unroll
                for (int gi = 0; gi < 4; ++gi) To[gi] = xh_get(T[gi], h);
                float R = carry;
#pragma unroll
                for (int gi = 3; gi >= 0; --gi) { const float Xg = h ? R : R * To[gi];
                    z[4 * gi] *= Xg; z[4 * gi + 1] *= Xg; z[4 * gi + 2] *= Xg; z[4 * gi + 3] *= Xg;
                    R *= T[gi] * To[gi]; }
                carry = R;
            }
            pv64(o0, o1, vb, 4096, s0, s1, lane);
            done = !__any(carry >= 9.0949470177e-13f);
        }
        if (lane == 0) flags[(i & 1) * 8 + X.wave] = (done || kt == 0) ? 1 : 0;
    }
    __syncthreads();
    half_t* dst = (half_t*)(a.ws + WS_ATT) + ((size_t)b * SEQ + tq) * DM + 512 + head * 64;
    store_col(dst, o0, o1, (ZM & 8) ? 0.f : 1.0f, h);
    __syncthreads();
}

__device__ __forceinline__ float bias_naive(const float* rel, int dist, int slot) { return rel[(int)kBucket[min(dist, 127)] * 16 + slot] * LOG2E; }
__device__ __forceinline__ void swa_naive(const Ctx& X, const Args& a) {
    const half_t* PR = (const half_t*)(a.ws + WS_PROJ);
    for (int item = blockIdx.x * 512 + X.tid; item < NT * 8; item += X.G * 512) {
        const int head = item & 7, row = item >> 3, t = row & (SEQ - 1), b = row >> 12, g = head >> 2;
        const half_t* prow = PR + (size_t)row * NPROJ;
        float q[64], o[64];
#pragma unroll
        for (int d = 0; d < 64; ++d) { q[d] = (float)prow[AB_QB + head * 64 + d]; o[d] = 0.f; }
        float m = a.sinks[head] * LOG2E, l = 1.f;
        for (int kp = max(0, t - 127); kp <= t; ++kp) {
            const half_t* kr = PR + ((size_t)b * SEQ + kp) * NPROJ + AB_KB + g * 64; const half_t* vr = PR + ((size_t)b * SEQ + kp) * NPROJ + AB_VB + g * 64;
            float s = 0.f;
#pragma unroll
            for (int d = 0; d < 64; ++d) s += q[d] * (float)kr[d];
            s += bias_naive(a.rel, t - kp, 8 + head);
            const float mn = fmaxf(m, s), al = exp2f(m - mn), p = exp2f(s - mn);
            l = l * al + p; m = mn;
#pragma unroll
            for (int d = 0; d < 64; ++d) o[d] = o[d] * al + p * (float)vr[d];
        }
        half_t* dst = (half_t*)(a.ws + WS_ATT) + (size_t)row * DM + 512 + head * 64;
#pragma unroll
        for (int d = 0; d < 64; ++d) dst[d] = (half_t)(o[d] / l);
    }
}
__device__ __forceinline__ void stick_naive(const Ctx& X, const Args& a) {
    const half_t* PR = (const half_t*)(a.ws + WS_PROJ);
    for (int item = blockIdx.x * 512 + X.tid; item < NT * 8; item += X.G * 512) {
        const int head = item & 7, row = item >> 3, t = row & (SEQ - 1), b = row >> 12;
        const half_t* prow = PR + (size_t)row * NPROJ;
        float q[64], o[64];
#pragma unroll
        for (int d = 0; d < 64; ++d) { q[d] = (float)prow[CD_QD + head * 64 + d]; o[d] = 0.f; }
        float carry = 1.f;
        for (int kp = t - 1; kp >= 0 && carry > 1e-30f; --kp) {
            const half_t* kr = PR + ((size_t)b * SEQ + kp) * NPROJ + CD_KD + head * 64; const half_t* vr = PR + ((size_t)b * SEQ + kp) * NPROJ + CD_VD + head * 64;
            float z = 0.f;
#pragma unroll
            for (int d = 0; d < 64; ++d) z += q[d] * (float)kr[d];
            const float e = exp2f(z), u = 1.0f / (1.0f + e), w = (1.0f - u) * carry;
            carry *= u;
#pragma unroll
            for (int d = 0; d < 64; ++d) o[d] += w * (float)vr[d];
        }
        half_t* dst = (half_t*)(a.ws + WS_ATT) + (size_t)row * DM + 512 + head * 64;
#pragma unroll
        for (int d = 0; d < 64; ++d) dst[d] = (half_t)o[d];
    }
}

__device__ __forceinline__ void moba_naive_pre(const Ctx& X, const Args& a) {
    const half_t* PR = (const half_t*)(a.ws + WS_PROJ); float* KMN = (float*)(a.ws + WS_Y) + (2u << 18);
    for (int item = blockIdx.x * 512 + X.tid; item < 8 * 16 * 2 * 64; item += X.G * 512) {
        const int d = item & 63, g = (item >> 6) & 1, j = (item >> 7) & 15, b = item >> 11;
        float s = 0.f;
        for (int k = 0; k < 256; ++k) s += (float)PR[((size_t)b * SEQ + 256 * j + k) * NPROJ + CD_KC + g * 64 + d];
        KMN[item] = s * (1.0f / 256.0f);
    }
}
__device__ __forceinline__ void moba_naive(const Ctx& X, const Args& a) {
    const half_t* PR = (const half_t*)(a.ws + WS_PROJ); const float* KMN = (const float*)(a.ws + WS_Y) + (2u << 18);
    for (int item = blockIdx.x * 512 + X.tid; item < NT * 8; item += X.G * 512) {
        const int head = item & 7, row = item >> 3, t = row & (SEQ - 1), b = row >> 12, g = head >> 2, ownb = t >> 8;
        const half_t* prow = PR + (size_t)row * NPROJ;
        float q[64], o[64];
#pragma unroll
        for (int d = 0; d < 64; ++d) { q[d] = (float)prow[CD_QC + head * 64 + d]; o[d] = 0.f; }
        unsigned sel = 0u;
        for (int rep = 0; rep < 3; ++rep) { float best = NEG_INF; int bi = -1;
            for (int j = 0; j < ownb; ++j) { if ((sel >> j) & 1u) continue; const float* km = KMN + (((size_t)b * 16 + j) * 2 + g) * 64; float s = 0.f;
#pragma unroll
                for (int d = 0; d < 64; ++d) s += q[d] * km[d];
                if (s > best) { best = s; bi = j; } }
            if (bi >= 0) sel |= 1u << bi; }
        float m = NEG_INF, l = 0.f;
        for (int j = 0; j <= ownb; ++j) {
            if (j < ownb && !((sel >> j) & 1u)) continue;
            const int kend = j < ownb ? 256 * j + 255 : t;
            for (int kp = 256 * j; kp <= kend; ++kp) {
                const half_t* kr = PR + ((size_t)b * SEQ + kp) * NPROJ + CD_KC + g * 64; const half_t* vr = PR + ((size_t)b * SEQ + kp) * NPROJ + CD_VC + g * 64;
                float s = 0.f;
#pragma unroll
                for (int d = 0; d < 64; ++d) s += q[d] * (float)kr[d];
                s += bias_naive(a.rel, t - kp, head);
                const float mn = fmaxf(m, s), al = exp2f(m - mn), p = exp2f(s - mn);
                l = l * al + p; m = mn;
#pragma unroll
                for (int d = 0; d < 64; ++d) o[d] = o[d] * al + p * (float)vr[d];
            }
        }
        half_t* dst = (half_t*)(a.ws + WS_ATT) + (size_t)row * DM + head * 64;
#pragma unroll
        for (int d = 0; d < 64; ++d) dst[d] = (half_t)(o[d] / l);
    }
}
__device__ __forceinline__ void nsa_naive_pre(const Ctx& X, const Args& a) {
    const half_t* PR = (const half_t*)(a.ws + WS_PROJ); float* KCN = (float*)(a.ws + WS_Y);
    for (int item = blockIdx.x * 512 + X.tid; item < 2 * 8 * 256 * 2 * 64; item += X.G * 512) {
        const int e = item & 63, g = (item >> 6) & 1, n = (item >> 7) & 255, b = (item >> 15) & 7, tsr = item >> 18;
        const float* W = tsr ? a.cmp_wv : a.cmp_wk; float s = 0.f;
        if (NVF & 2) { KCN[item] = (float)((const half_t*)(a.ws + (tsr ? WS_VCMP : WS_KCMP)))[((size_t)(b * 2 + g) * 256 + n) * 64 + e]; continue; }
        if (n < 255) for (int l = 0; l < 32; ++l) for (int d = 0; d < 64; ++d)
            s += ((float)PR[((size_t)b * SEQ + 16 * n + l) * NPROJ + (tsr ? AB_VC : AB_KC) + g * 64 + d] + a.cmp_pe[l * 64 + d]) * W[(l * 64 + d) * 64 + e];
        KCN[item] = s;
    }
}
__device__ __forceinline__ void nsa_naive(const Ctx& X, const Args& a) {
    const half_t* PR = (const half_t*)(a.ws + WS_PROJ); const half_t* Hh = (const half_t*)(a.ws + WS_H);
    const float* KCN = (const float*)(a.ws + WS_Y); const float* VCN = KCN + (1u << 18);
    float* IMPN = (float*)(a.ws + WS_Y) + (1u << 20);
    for (int item = blockIdx.x * 512 + X.tid; item < NT * 8; item += GRID * 512) {
        const int head = item & 7, row = item >> 3, t = row & (SEQ - 1), b = row >> 12, g = head >> 2, own = t >> 6;
        const half_t* prow = PR + (size_t)row * NPROJ;
        float* outp = a.out + (size_t)item * 64;
        const half_t* q = prow + AB_QA + head * 64;
        float gt[3];
#pragma unroll
        for (int br = 0; br < 3; ++br) { float s = 0.f;
            if (NVF & 1) { gt[br] = (float)((const half_t*)(a.ws + WS_GATE))[(size_t)row * 32 + head * 3 + br]; }
            else { for (int k = 0; k < 1024; ++k) s += (float)Hh[(size_t)row * DM + k] * a.w_in_ab[(size_t)k * 2072 + 1280 + head * 3 + br]; gt[br] = 1.0f / (1.0f + expf(-s)); } }
        const int nv = t >= 31 ? (t - 31) / 16 + 1 : 0;
        float m = NEG_INF, l = 0.f;
        for (int n = 0; n < nv; ++n) { const float* kc = KCN + ((((size_t)b * 256 + n) * 2 + g) * 64); float s = 0.f;
            for (int d = 0; d < 64; ++d) s += (float)q[d] * kc[d];
            s += bias_naive(a.rel, t - (16 * n + 31), head);
            const float mn = fmaxf(m, s); l = l * exp2f(m - mn) + exp2f(s - mn); m = mn; }
        for (int d = 0; d < 64; ++d) outp[d] = 0.f;
        for (int n = 0; n < nv; ++n) { const float* kc = KCN + ((((size_t)b * 256 + n) * 2 + g) * 64); const float* vc = VCN + ((((size_t)b * 256 + n) * 2 + g) * 64); float s = 0.f;
            for (int d = 0; d < 64; ++d) s += (float)q[d] * kc[d];
            s += bias_naive(a.rel, t - (16 * n + 31), head);
            const float p = ((NBR & 1) && NBR != 7 ? 0.f : gt[0]) * exp2f(s - m) / l;
            for (int d = 0; d < 64; ++d) outp[d] += p * vc[d]; }
        for (int s_ = 0; s_ < 64; ++s_) { float im = 0.f;
            for (int k = -1; k < 4; ++k) { const int n = 4 * s_ + k; if (n < 0 || n >= nv) continue; const float* kc = KCN + ((((size_t)b * 256 + n) * 2 + g) * 64); float s = 0.f;
                for (int d = 0; d < 64; ++d) s += (float)q[d] * kc[d];
                s += bias_naive(a.rel, t - (16 * n + 31), head);
                im += ((k == -1 || k == 3) ? 0.5f : 1.0f) * exp2f(s - m) / l; }
            im = quad_sum(im);
            IMPN[(size_t)item * 64 + s_] = im; }
        unsigned long long sel = 0ull;
        for (int rep = 0; rep < 8; ++rep) { float best = -3e38f; int bi = -1;
            for (int s_ = 0; s_ <= own; ++s_) { if ((sel >> s_) & 1ull) continue; const bool forced = s_ == 0 || s_ == own || s_ == own - 1;
                const float key = IMPN[(size_t)item * 64 + s_] + (forced ? 1e4f : 0.f); if (key > best) { best = key; bi = s_; } }
            if (bi >= 0) sel |= 1ull << bi; }
        m = NEG_INF; l = 0.f;
        for (int s_ = 0; s_ <= own; ++s_) { if (!((sel >> s_) & 1ull)) continue;
            for (int kp = 64 * s_; kp <= min(64 * s_ + 63, t); ++kp) { const half_t* kr = PR + ((size_t)b * SEQ + kp) * NPROJ + AB_KS + g * 64; float s = 0.f;
                for (int d = 0; d < 64; ++d) s += (float)q[d] * (float)kr[d];
                s += bias_naive(a.rel, t - kp, head);
                const float mn = fmaxf(m, s); l = l * exp2f(m - mn) + exp2f(s - mn); m = mn; } }
        for (int s_ = 0; s_ <= own; ++s_) { if (!((sel >> s_) & 1ull)) continue;
            for (int kp = 64 * s_; kp <= min(64 * s_ + 63, t); ++kp) { const half_t* kr = PR + ((size_t)b * SEQ + kp) * NPROJ + AB_KS + g * 64; const half_t* vr = PR + ((size_t)b * SEQ + kp) * NPROJ + AB_VS + g * 64; float s = 0.f;
                for (int d = 0; d < 64; ++d) s += (float)q[d] * (float)kr[d];
                s += bias_naive(a.rel, t - kp, head);
                const float p = ((NBR & 2) && NBR != 7 ? 0.f : gt[1]) * exp2f(s - m) / l;
                for (int d = 0; d < 64; ++d) outp[d] += p * (float)vr[d]; } }
        m = NEG_INF; l = 0.f;
        for (int kp = max(0, t - 511); kp <= t; ++kp) { const half_t* kr = PR + ((size_t)b * SEQ + kp) * NPROJ + AB_KW + g * 64; float s = 0.f;
            for (int d = 0; d < 64; ++d) s += (float)q[d] * (float)kr[d];
            s += bias_naive(a.rel, t - kp, head);
            const float mn = fmaxf(m, s); l = l * exp2f(m - mn) + exp2f(s - mn); m = mn; }
        for (int kp = max(0, t - 511); kp <= t; ++kp) { const half_t* kr = PR + ((size_t)b * SEQ + kp) * NPROJ + AB_KW + g * 64; const half_t* vr = PR + ((size_t)b * SEQ + kp) * NPROJ + AB_VW + g * 64; float s = 0.f;
            for (int d = 0; d < 64; ++d) s += (float)q[d] * (float)kr[d];
            s += bias_naive(a.rel, t - kp, head);
            const float p = ((NBR & 4) && NBR != 7 ? 0.f : gt[2]) * exp2f(s - m) / l;
            for (int d = 0; d < 64; ++d) outp[d] += p * (float)vr[d]; }
        half_t* dst = (half_t*)(a.ws + WS_ATT) + (size_t)row * DM + head * 64;
        for (int d = 0; d < 64; ++d) dst[d] = (half_t)outp[d];
    }
}

__device__ __forceinline__ void balanced_unit(int vcu, int i, int& bg, int& tile) {
    const int s = vcu & 15; bg = vcu >> 4; tile = (i == 0) ? s : (i == 1) ? 31 - s : (i == 2) ? 32 + s : 63 - s;
}

template <class Epi> __device__ __forceinline__ void run_gemm(const Ctx& X, const half_t* A, const half_t* Bt, int N, int K, const Epi& E) {
    pg8::Gemm g{A, Bt, NT, N, K}; pg8::StaticOrder S; S.init(NT, N, X.G, (int)blockIdx.x);
    pg8::gemm_phase<Epi, pg8::StaticOrder, true>(X.L, X.tid, g, S, E);
}
__device__ __forceinline__ Ctx make_ctx(ldsp L) {
    Ctx X; int t = threadIdx.x; asm volatile("" : "+v"(t));
    X.L = L; X.tid = t; X.lane = t & 63; X.wave = __builtin_amdgcn_readfirstlane(t >> 6);
    X.G = GRID; { const int bx = blockIdx.x; X.vcu = (bx % 8) * (GRID / 8) + bx / 8; }
    return X;
}

__global__ void __launch_bounds__(512, 2) fwd_kernel(Args a_in) {
    extern __shared__ __attribute__((aligned(16))) unsigned char lds_raw[];
    cg::grid_group grid = cg::this_grid();
    const ldsp L = (ldsp)lds_raw;
    if (threadIdx.x < 2) ((LAS unsigned*)(L + L_XB))[threadIdx.x] = 0u;
    __syncthreads();
    const XcdBarrier xbar = xcd_barrier_post((unsigned*)a_in.ws, (volatile LAS unsigned*)(L + L_XB));
    for (int step = 0; step < 18; ++step) {
        Args a = a_in; { unsigned char* w_ = a_in.ws; asm volatile("" : "+s"(w_)); a.ws = w_; }
        unsigned char* ws = a.ws;
        const float* modv = (const float*)(ws + WS_MODV);
        const int layer = step < 2 ? 0 : (step - 2) >> 3, q = step < 2 ? step - 2 : (step - 2) & 7;
        half_t* H = (half_t*)(ws + WS_H); half_t* PROJ = (half_t*)(ws + WS_PROJ); half_t* ATT = (half_t*)(ws + WS_ATT); half_t* HID = (half_t*)(ws + WS_HID); float* Y = (float*)(ws + WS_Y);
        const int kbit = q == -2 ? 0 : q == 0 ? 1 : (q == 3 || q == 6) ? 2 : q == 5 ? 3 : q == 1 ? 4 + 2 * layer : q == 2 ? 5 + 2 * layer : 31;
        const int nrep = ((REP >> kbit) & 1) ? 2 : 1;
        for (int rep = 0; rep < nrep; ++rep) {
        if (rep) __syncthreads();
        if (q == -2) { const Ctx X = make_ctx(L); if (PH & 1) phase_prologue(X, a); }
        else if (q == -1 || q == 4 || q == 7) {
            const Ctx X = make_ctx(L);
            const bool has_y = q >= 0, do_h = !(q == 7 && layer == 1);
            const int ls_post = layer * 2 + (q == 7 ? 1 : 0), ls_pre = q == -1 ? 0 : (q == 4 ? layer * 2 + 1 : 2);
            const float* xin = (q == -1 || (q == 4 && layer == 0)) ? a.x : a.out;
            if (PH & 2) rows_phase(X, has_y, do_h, xin, Y, a.out, H, a.norm_w + (size_t)(ls_post * 2 + 1) * 1024, modv + (size_t)ls_post * 8 * 3072,
                       a.norm_w + (size_t)(ls_pre * 2 + 0) * 1024, modv + (size_t)ls_pre * 8 * 3072);
        }
        else if (q == 0) {
            const Ctx X = make_ctx(L);
            pg8::EpiProj E{PROJ, NPROJ, layer == 0 ? 0x63u : 0x1Bu};
            if (PH & 4) run_gemm(X, H, (const half_t*)(ws + (layer == 0 ? WS_WAB : WS_WCD)), layer == 0 ? 2048 : NPROJ, 1024, E);
        }
        else if (q == 1) {
            if (layer == 0) {
                const Ctx X = make_ctx(L);
                if (PH & 8) for (int j = X.vcu * 8 + X.wave; j < 1024; j += X.G * 8) gate_job(X, a, j);
                if (PH & 16) for (int j = X.vcu; j < 256; j += X.G) compress_job(X, a, j);
                build_bias(X, a.rel, 8);
                if (NV & 2) swa_naive(X, a); else
                if (PH & 32) for (int u = X.vcu; u < 1024; u += X.G) swa_unit(X, a, u >> 7, (u >> 6) & 1, u & 63);
            } else {
                const Ctx X = make_ctx(L);
                if (PH & 64) for (int j = X.vcu; j < 256; j += X.G) kmean_job(X, a, j);
                if (NV & 4) moba_naive_pre(X, a);
                if (NV & 8) stick_naive(X, a); else
                if (PH & 128) for (int u = X.vcu; u < 1024; u += X.G) stick_unit(X, a, u >> 7, (u >> 4) & 7, u & 15);
            }
        }
        else if (q == 2) {
            const Ctx X0 = make_ctx(L); build_bias(X0, a.rel, 0);
            if (layer == 0 && (NV & 1)) { const Ctx X = make_ctx(L); nsa_naive_pre(X, a); grid.sync(); nsa_naive(X, a); if (NBR != 7) grid.sync(); }
            if (layer == 1 && (NV & 4)) { const Ctx X = make_ctx(L); moba_naive(X, a); }
            else if (layer == 0) { const Ctx X = make_ctx(L); if (!(NV & 1) || NBR != 7) { for (int i = 0; i < 1024; i += X.G) { const int u = i + X.vcu; if (u < 1024) { int bg, tile; balanced_unit(u & 255, u >> 8, bg, tile); if (PH & 256) nsa_unit(X, a, bg >> 1, bg & 1, tile); } } } }
            else            { const Ctx X = make_ctx(L); for (int i = 0; i < 1024; i += X.G) { const int u = i + X.vcu; if (u < 1024) { int bg, tile; balanced_unit(u & 255, u >> 8, bg, tile); if (PH & 512) moba_unit(X, a, bg >> 1, bg & 1, tile); } } }
        }
        else if (q == 3 || q == 6) {
            const Ctx X = make_ctx(L);
            pg8::EpiF32 E{Y, DM};
            const half_t* Aop = q == 3 ? ATT : HID;
            const half_t* Bop = q == 3 ? (const half_t*)(ws + (layer == 0 ? WS_WOAB : WS_WOCD)) : (const half_t*)(ws + WS_WFO) + (size_t)layer * 1024 * DFF;
            if (PH & 1024) run_gemm(X, Aop, Bop, DM, q == 3 ? 1024 : DFF, E);
        }
        else {
            const Ctx X = make_ctx(L);
            pg8::EpiSwiGLU E{HID, DFF}; if (PH & 2048) run_gemm(X, H, (const half_t*)(ws + WS_WFI) + (size_t)layer * NFF * 1024, NFF, 1024, E);
        }
        }
        if (step != 17) { if (!USE_XB || step == 0) grid.sync(); else xcd_barrier(xbar); if (REP & 256) { grid.sync(); grid.sync(); } if (REP & 512) { xcd_barrier(xbar); xcd_barrier(xbar); } }
    }
}

extern "C" void kernel_launch(void* const* d_in, const int* in_sizes, int n_in, void* d_out, int out_size, void* d_ws, size_t ws_size, hipStream_t stream) {
    static int grid = 0;
    if (grid == 0) {
        if (n_in != 16 || out_size != NT * DM || ws_size < WS_END) { fprintf(stderr, "kernel_launch: unexpected problem (n_in %d out %d ws %zu)\n", n_in, out_size, ws_size); grid = -1; return; }
        int dev = 0, cus = 0, per_cu = 0;
        hipGetDevice(&dev); hipDeviceGetAttribute(&cus, hipDeviceAttributeMultiprocessorCount, dev);
        hipFuncSetAttribute((const void*)fwd_kernel, hipFuncAttributeMaxDynamicSharedMemorySize, LDS_BYTES);
        hipOccupancyMaxActiveBlocksPerMultiprocessor(&per_cu, (const void*)fwd_kernel, 512, LDS_BYTES);
        if (per_cu < 1) { fprintf(stderr, "kernel_launch: occupancy query says %d blocks per CU\n", per_cu); per_cu = 1; }
        if (cus * per_cu < GRID) { fprintf(stderr, "kernel_launch: device holds %d x %d workgroups, kernel built for %d\n", cus, per_cu, GRID); grid = -1; return; }
        grid = GRID;
        (void)hipGetLastError();
    }
    if (grid < 0) return;
    if (hipMemsetAsync(d_ws, 0, 16384, stream) != hipSuccess) { fprintf(stderr, "kernel_launch: memset of the barrier words failed\n"); return; }
    Args a{};
    a.x = (const float*)d_in[0]; a.c = (const float*)d_in[1]; a.rel = (const float*)d_in[2]; a.mod_w = (const float*)d_in[3]; a.mod_b = (const float*)d_in[4]; a.norm_w = (const float*)d_in[5];
    a.w_in_ab = (const float*)d_in[6]; a.w_out_ab = (const float*)d_in[7]; a.cmp_wk = (const float*)d_in[8]; a.cmp_wv = (const float*)d_in[9]; a.cmp_pe = (const float*)d_in[10]; a.sinks = (const float*)d_in[11];
    a.w_in_cd = (const float*)d_in[12]; a.w_out_cd = (const float*)d_in[13]; a.ffn_w_in = (const float*)d_in[14]; a.ffn_w_out = (const float*)d_in[15];
    a.out = (float*)d_out; a.ws = (unsigned char*)d_ws;
    void* args[] = {&a};
    hipError_t e = hipLaunchCooperativeKernel((const void*)fwd_kernel, dim3(grid), dim3(512), args, LDS_BYTES, stream);
    if (e != hipSuccess) fprintf(stderr, "cooperative launch failed: %s (grid %d)\n", hipGetErrorString(e), grid);
}
```
